# Optimizing an MI355X kernel written in HIP

```python
import jax, jax.numpy as jnp
from jax import lax
import numpy as np

D_MODEL = 2048
BATCH = 32
SEQ = 256
DEPTH = 4
DEC_BATCH = 4
DEC_SEQ = 4096
PAST_LEN = 512

GRID_W = 64
N_EVEN = (DEPTH + 1) // 2
N_ODD = DEPTH // 2
N_MOD = 6
EPS = 1e-6
D_A = D_MODEL
A_GROUPS = 8
A_CH = D_A // A_GROUPS
CHUNK = 128
D_B = D_MODEL
SSD_HEAD_DIM = 64
SSD_HEADS = D_B // SSD_HEAD_DIM
SSD_GROUPS = 4
D_STATE = 128
D_CONV = 5
SSD_CHUNK = 128
C_CONV = D_B + 2 * SSD_GROUPS * D_STATE
IN_EVEN = 2 * D_A + D_B + C_CONV + 2 * SSD_HEADS
D_C = D_MODEL
POOL_WINDOWS = (2, 4, 8, 16)
POOL_CH = D_C // len(POOL_WINDOWS)
D_FF = -(-8 * D_MODEL // (3 * 256)) * 256

kernel_name = "hybrid_gmlp_ssd_pool_diffusion_step"

F32 = jnp.float32


def rmsnorm(x, w):
    xf = x.astype(F32)
    y = xf * lax.rsqrt(jnp.mean(xf * xf, axis=-1, keepdims=True) + EPS)
    return (y * w.astype(F32)).astype(x.dtype)


def modulate(h, shift, scale):
    return h * (1 + scale) + shift


def chunk_gmlp(u, v, ws, bs, vnorm):
    b, l, _ = u.shape
    nc = l // CHUNK
    u = jax.nn.gelu(u)
    v = jax.nn.gelu(v).reshape(b, nc, CHUNK, A_GROUPS, A_CH)
    v = rmsnorm(v, vnorm.reshape(A_GROUPS, A_CH))
    sv = jnp.einsum('gts,bcsgk->bctgk', ws, v) + bs.T[:, :, None]
    return u * sv.reshape(b, l, D_A)


def centred_conv(x, w, bias):
    l = x.shape[1]
    pad = D_CONV // 2
    xp = jnp.pad(x, ((0, 0), (pad, pad), (0, 0)))
    out = bias
    for k in range(D_CONV):
        out = out + w[k] * xp[:, k:k + l]
    return out


def segsum(a):
    t = a.shape[-1]
    cs = jnp.cumsum(a, axis=-1)
    diff = cs[..., :, None] - cs[..., None, :]
    mask = jnp.tril(jnp.ones((t, t), dtype=bool))
    return jnp.where(mask, diff, -jnp.inf)


def ssd_scan(x, dt, a_log, bm, cm, h0):
    b, l, h, p = x.shape
    q = SSD_CHUNK
    nc = l // q
    j = h // SSD_GROUPS
    dtf = dt.astype(F32)
    a = dtf * (-jnp.exp(a_log.astype(F32)))
    a = a.reshape(b, nc, q, SSD_GROUPS, j).transpose(0, 3, 4, 1, 2)
    a_cs = jnp.cumsum(a, axis=-1)
    xg = (x.astype(F32) * dtf[..., None]).reshape(b, nc, q, SSD_GROUPS, j, p)
    bc = bm.astype(F32).reshape(b, nc, q, SSD_GROUPS, D_STATE)
    cc = cm.astype(F32).reshape(b, nc, q, SSD_GROUPS, D_STATE)
    cb = jnp.einsum('bclgn,bcsgn->bgcls', cc, bc)
    m = cb[:, :, None] * jnp.exp(segsum(a))
    y_diag = jnp.einsum('bgjcls,bcsgjp->bclgjp', m, xg)
    decay_states = jnp.exp(a_cs[..., -1:] - a_cs)
    states = jnp.einsum('bcsgn,bgjcs,bcsgjp->bcgjpn', bc, decay_states, xg)
    init = h0.astype(F32).reshape(b, 1, SSD_GROUPS, j, p, D_STATE)
    states = jnp.concatenate([init, states], axis=1)
    chunk_tot = jnp.pad(a_cs[..., -1], ((0, 0), (0, 0), (0, 0), (1, 0)))
    decay_chunk = jnp.exp(segsum(chunk_tot))
    new_states = jnp.einsum('bgjzc,bcgjpn->bzgjpn', decay_chunk, states)
    y_off = jnp.einsum('bclgn,bcgjpn,bgjcl->bclgjp', cc, new_states[:, :-1], jnp.exp(a_cs))
    y = (y_diag + y_off).reshape(b, l, h, p)
    final = new_states[:, -1].reshape(b, h, p, D_STATE)
    return y.astype(x.dtype), final


def ssd_mixer(z, xbc, dt_f, dt_b, conv_w, conv_b, dt_bias, a_log, d_skip, norm_w, h0):
    b, l, _ = z.shape
    gn = SSD_GROUPS * D_STATE
    xbc = jax.nn.silu(centred_conv(xbc, conv_w, conv_b))
    xs = xbc[..., :D_B].reshape(b, l, SSD_HEADS, SSD_HEAD_DIM)
    bm = xbc[..., D_B:D_B + gn].reshape(b, l, SSD_GROUPS, D_STATE)
    cm = xbc[..., D_B + gn:].reshape(b, l, SSD_GROUPS, D_STATE)
    dtf = jax.nn.softplus(dt_f.astype(F32) + dt_bias[0].astype(F32))
    dtb = jax.nn.softplus(dt_b.astype(F32) + dt_bias[1].astype(F32))
    y_f, s_f = ssd_scan(xs, dtf, a_log[0], bm, cm, h0[:, 0])
    y_b, s_b = ssd_scan(jnp.flip(xs, 1), jnp.flip(dtb, 1), a_log[1],
                        jnp.flip(bm, 1), jnp.flip(cm, 1), h0[:, 1])
    y = y_f + jnp.flip(y_b, 1) + d_skip[:, None] * xs
    y = rmsnorm(y.reshape(b, l, D_B) * jax.nn.silu(z), norm_w)
    return y, jnp.stack([s_f, s_b], axis=1)


def window_mean(x4, k):
    w = x4.shape[2]
    s = jnp.pad(jnp.cumsum(x4.astype(F32), axis=2), ((0, 0), (0, 0), (1, 0), (0, 0)))
    t = jnp.arange(w)
    lo = jnp.maximum(t - k // 2, 0)
    hi = jnp.minimum(t - k // 2 + k, w)
    tot = jnp.take(s, hi, axis=2) - jnp.take(s, lo, axis=2)
    return (tot / (hi - lo).astype(F32)[:, None]).astype(x4.dtype)


def pool_mixer(hc, rows, w_grp, scale):
    b, l, _ = hc.shape
    x4 = hc.reshape(b, rows, l // rows, D_C)
    pooled = jnp.concatenate(
        [window_mean(x4[..., g * POOL_CH:(g + 1) * POOL_CH], k) for g, k in enumerate(POOL_WINDOWS)],
        axis=-1) - x4
    pooled = pooled.reshape(b, l, len(POOL_WINDOWS), POOL_CH)
    out = jnp.einsum('blgc,gcd->blgd', pooled, w_grp).reshape(b, l, D_C)
    return out * scale


def setup_inputs(seed: int = 0) -> dict:
    key = jax.random.key(seed)
    ks = jax.random.split(key, 32)
    nrm = lambda k, s, sc: jax.random.normal(k, s, F32) * sc
    gain = lambda k, s: 1.0 + 0.01 * jax.random.normal(k, s, F32)
    x_prompt = nrm(ks[0], (BATCH, SEQ, D_MODEL), 1.0)
    x_sample = nrm(ks[1], (DEC_BATCH, DEC_SEQ, D_MODEL), 1.0)
    state_ssd = nrm(ks[2], (DEC_BATCH, N_EVEN, 2, SSD_HEADS, SSD_HEAD_DIM, D_STATE), 0.5)
    c = nrm(ks[3], (DEC_BATCH, D_MODEL), 1.0)
    c_ctx = nrm(ks[4], (D_MODEL,), 1.0)
    w_mod = nrm(ks[5], (DEPTH, D_MODEL, N_MOD * D_MODEL), D_MODEL ** -0.5)
    b_mod = nrm(ks[6], (DEPTH, N_MOD * D_MODEL), 0.01)
    norm_mix = gain(ks[7], (DEPTH, D_MODEL))
    norm_ffn = gain(ks[8], (DEPTH, D_MODEL))
    w_in_even = nrm(ks[9], (N_EVEN, D_MODEL, IN_EVEN), D_MODEL ** -0.5)
    w_in_even = w_in_even.at[..., IN_EVEN - 2 * SSD_HEADS:].multiply(0.1)
    w_out_even = nrm(ks[10], (N_EVEN, D_A + D_B, D_MODEL), (D_A + D_B) ** -0.5)
    gmlp_norm = gain(ks[11], (N_EVEN, D_A))
    gmlp_ws = nrm(ks[12], (N_EVEN, A_GROUPS, CHUNK, CHUNK), CHUNK ** -0.5)
    gmlp_bs = nrm(ks[13], (N_EVEN, A_GROUPS, CHUNK), 0.01)
    ssd_conv_w = nrm(ks[14], (N_EVEN, D_CONV, C_CONV), D_CONV ** -0.5)
    ssd_conv_b = nrm(ks[15], (N_EVEN, C_CONV), 0.01)
    dt0 = jnp.exp(jax.random.uniform(ks[16], (N_EVEN, 2, SSD_HEADS), F32,
                                     float(np.log(1e-3)), float(np.log(1e-1))))
    ssd_dt_bias = dt0 + jnp.log(-jnp.expm1(-dt0))
    ssd_a_log = jnp.log(jax.random.uniform(ks[17], (N_EVEN, 2, SSD_HEADS), F32, 1.0, 16.0))
    ssd_d = gain(ks[18], (N_EVEN, SSD_HEADS))
    ssd_norm = gain(ks[19], (N_EVEN, D_B))
    w_in_odd = nrm(ks[20], (N_ODD, D_MODEL, D_C), D_MODEL ** -0.5)
    pool_w = nrm(ks[21], (N_ODD, len(POOL_WINDOWS), POOL_CH, POOL_CH), POOL_CH ** -0.5)
    pool_scale = gain(ks[22], (N_ODD, D_C))
    w_out_odd = nrm(ks[23], (N_ODD, D_C, D_MODEL), D_C ** -0.5)
    ffn_w1 = nrm(ks[24], (DEPTH, D_MODEL, D_FF), D_MODEL ** -0.5)
    ffn_w3 = nrm(ks[25], (DEPTH, D_MODEL, D_FF), D_MODEL ** -0.5)
    ffn_w2 = nrm(ks[26], (DEPTH, D_FF, D_MODEL), D_FF ** -0.5)
    final_norm = gain(ks[27], (D_MODEL,))
    return {"x_prompt": x_prompt, "x_sample": x_sample, "state_ssd": state_ssd, "c": c, "c_ctx": c_ctx,
            "w_mod": w_mod, "b_mod": b_mod, "norm_mix": norm_mix, "norm_ffn": norm_ffn,
            "w_in_even": w_in_even, "w_out_even": w_out_even, "gmlp_norm": gmlp_norm,
            "gmlp_ws": gmlp_ws, "gmlp_bs": gmlp_bs, "ssd_conv_w": ssd_conv_w, "ssd_conv_b": ssd_conv_b,
            "ssd_dt_bias": ssd_dt_bias, "ssd_a_log": ssd_a_log, "ssd_d": ssd_d, "ssd_norm": ssd_norm,
            "w_in_odd": w_in_odd, "pool_w": pool_w, "pool_scale": pool_scale, "w_out_odd": w_out_odd,
            "ffn_w1": ffn_w1, "ffn_w3": ffn_w3, "ffn_w2": ffn_w2, "final_norm": final_norm}


def reference(x_prompt, x_sample, state_ssd, c, c_ctx, w_mod, b_mod, norm_mix, norm_ffn,
              w_in_even, w_out_even, gmlp_norm, gmlp_ws, gmlp_bs, ssd_conv_w, ssd_conv_b,
              ssd_dt_bias, ssd_a_log, ssd_d, ssd_norm, w_in_odd, pool_w, pool_scale, w_out_odd,
              ffn_w1, ffn_w3, ffn_w2, final_norm):
    splits = [D_A, 2 * D_A, 2 * D_A + D_B, 2 * D_A + D_B + C_CONV, 2 * D_A + D_B + C_CONV + SSD_HEADS]

    def run(x, cond, rows, state0):
        finals = []
        for i in range(DEPTH):
            mod = (jax.nn.silu(cond) @ w_mod[i] + b_mod[i])[:, None, :]
            sh1, sc1, g1, sh2, sc2, g2 = jnp.split(mod, N_MOD, axis=-1)
            h = modulate(rmsnorm(x, norm_mix[i]), sh1, sc1)
            if i % 2 == 0:
                e = i // 2
                u, v, z, xbc, dt_f, dt_b = jnp.split(h @ w_in_even[e], splits, axis=-1)
                a_out = chunk_gmlp(u, v, gmlp_ws[e], gmlp_bs[e], gmlp_norm[e])
                b_out, fin = ssd_mixer(z, xbc, dt_f, dt_b, ssd_conv_w[e], ssd_conv_b[e], ssd_dt_bias[e],
                                       ssd_a_log[e], ssd_d[e], ssd_norm[e], state0[:, e])
                finals.append(fin)
                out = jnp.concatenate([a_out, b_out], axis=-1) @ w_out_even[e]
            else:
                o = i // 2
                out = pool_mixer(h @ w_in_odd[o], rows, pool_w[o], pool_scale[o]) @ w_out_odd[o]
            x = x + g1 * out
            h = modulate(rmsnorm(x, norm_ffn[i]), sh2, sc2)
            x = x + g2 * ((jax.nn.silu(h @ ffn_w1[i]) * (h @ ffn_w3[i])) @ ffn_w2[i])
        return rmsnorm(x, final_norm), jnp.stack(finals, axis=1)

    zeros = jnp.zeros((x_prompt.shape[0], N_EVEN, 2, SSD_HEADS, SSD_HEAD_DIM, D_STATE), F32)
    y_prompt, state_ssd_new = run(x_prompt, c_ctx[None, :], 1, zeros)
    rows = x_sample.shape[1] // GRID_W
    y_sample, _ = run(x_sample, c, rows, state_ssd)
    return (y_prompt, y_sample, state_ssd_new)
```

```cpp
#include <hip/hip_runtime.h>
#include <cstdio>
#include <cstdint>

#ifndef MK_PER_PHASE
#define MK_PER_PHASE 1
#endif

constexpr int D = 2048, MC = 8192, MS = 16384, M = MC + MS, DEPTH = 4, FF = 5632, NFU = 2 * FF;
constexpr int IN_EVEN = 9280, IN_PAD = 9472, PROJ_LD = 9216, CCONV = 3072;
constexpr int NH = 32, HP = 64, NST = 128;
constexpr int SEQ_C = 256, NB_C = 32, SEQ_S = 4096, NB_S = 4;
constexpr int NMOD = 6 * D;
constexpr float EPS = 1e-6f;
constexpr int NWAVES = 8, NTHR = 512;

constexpr size_t MiB = 1u << 20;
constexpr size_t WS_CTL = 0, CTL_ZERO_BYTES = 1 * MiB;
constexpr size_t WS_MOD = 1 * MiB;
constexpr size_t WS_WINE = 4 * MiB;
constexpr size_t WS_WOUTE = 78 * MiB;
constexpr size_t WS_WINO = 110 * MiB;
constexpr size_t WS_WOUTO = 126 * MiB;
constexpr size_t WS_WPOOL = 142 * MiB;
constexpr size_t WS_WUP = 146 * MiB;
constexpr size_t WS_WDN = 322 * MiB;
constexpr size_t WS_X = 410 * MiB;
constexpr size_t WS_H = 602 * MiB;
constexpr size_t WS_PROJ = 698 * MiB;
constexpr size_t WS_G = WS_PROJ;
constexpr size_t WS_HC = WS_PROJ;
constexpr size_t WS_PL = WS_PROJ + 96 * MiB;
constexpr size_t WS_PO = WS_PROJ + 192 * MiB;
constexpr size_t WS_DT = 1130 * MiB;
constexpr size_t WS_AB = 1136 * MiB;
constexpr size_t WS_YF = 1328 * MiB;
constexpr size_t WS_YB = 1424 * MiB;
constexpr size_t WS_END = 1520 * MiB;
static_assert(WS_WINE + (size_t)2 * IN_PAD * D * 2 <= WS_WOUTE, "map");
static_assert(WS_WUP + (size_t)4 * NFU * D * 2 <= WS_WDN && WS_WDN + (size_t)4 * D * FF * 2 <= WS_X, "map");
static_assert(WS_X + (size_t)M * D * 4 <= WS_H && WS_H + (size_t)M * D * 2 <= WS_PROJ, "map");
static_assert(WS_PROJ + (size_t)M * PROJ_LD * 2 <= WS_DT && WS_DT + (size_t)M * 64 * 4 <= WS_AB, "map");
static_assert(WS_AB + (size_t)M * 4096 * 2 <= WS_YF && WS_YB + (size_t)M * D * 2 <= WS_END, "map");
constexpr int CW_TMO = 0;
constexpr int CW_BAR = 4096;

constexpr int RING_BYTES = 131072;
constexpr int LDS_BYTES = 155648;
constexpr int MISC_OFF = LDS_BYTES - 256;

#define GAS __attribute__((address_space(1)))
#define LAS __attribute__((address_space(3)))
typedef unsigned short bf16;
typedef unsigned v4u __attribute__((ext_vector_type(4)));
typedef unsigned v2u __attribute__((ext_vector_type(2)));
typedef float f32x4 __attribute__((ext_vector_type(4)));
typedef float f32x2 __attribute__((ext_vector_type(2)));
typedef short bf16x8 __attribute__((ext_vector_type(8)));
#define LDS_WAIT() asm volatile("s_waitcnt lgkmcnt(0)" ::: "memory")
#define VM_WAIT() asm volatile("s_waitcnt vmcnt(0)" ::: "memory")

__device__ __forceinline__ unsigned f2bf(float f) { unsigned u = __builtin_bit_cast(unsigned, f); return (u + 0x7fffu + ((u >> 16) & 1u)) >> 16; }
__device__ __forceinline__ unsigned pk2(float lo, float hi) { return f2bf(lo) | (f2bf(hi) << 16); }
__device__ __forceinline__ float bf2f(unsigned b) { return __builtin_bit_cast(float, b << 16); }
__device__ __forceinline__ float bflo(unsigned w) { return __builtin_bit_cast(float, w << 16); }
__device__ __forceinline__ float bfhi(unsigned w) { return __builtin_bit_cast(float, w & 0xffff0000u); }
__device__ __forceinline__ float silu_f(float x) { return x / (1.0f + __expf(-x)); }
__device__ __forceinline__ float gelu_tanh_f(float x) {
    const float y = 0.7978845608028654f * (x + 0.044715f * x * x * x);
    const float t = 1.0f - 2.0f / (__expf(2.0f * y) + 1.0f);
    return 0.5f * x * (1.0f + t);
}
__device__ __forceinline__ float softplus_f(float x) { return x > 20.f ? x : log1pf(__expf(x)); }
__device__ __forceinline__ float wave_sum(float v) {
#pragma unroll
    for (int o = 1; o < 64; o <<= 1) v += __shfl_xor(v, o);
    return v;
}
__device__ __forceinline__ int cond_idx(int row) { return row < MC ? 4 : ((row - MC) >> 12); }

namespace pg8 {
#define PG8_LAS __attribute__((address_space(3)))
typedef unsigned short bf16_t;
constexpr int BM = 256, BK = 64, HALF = 128, HTB = HALF * BK * 2, STAGE_BYTES = 8 * HTB, NXCD = 8, WGM = 8;
__host__ __device__ __forceinline__ int lds_byte(int r, int c) { const int st = (r >> 4) * 2 + (c >> 5), rr = r & 15, cc = c & 31, ob = rr * 64 + cc * 2; return st * 1024 + (ob ^ (((ob >> 9) & 1) << 5)); }
__host__ __device__ __forceinline__ void stage_rc(int b, int& R, int& C) { const int st = b / 1024, sb = b % 1024, swz = sb ^ (((sb >> 9) & 1) << 5); R = (st >> 1) * 16 + swz / 64; C = (st & 1) * 32 + (swz % 64) / 2; }
__host__ __device__ __forceinline__ int perm32(int rho) { const int n = rho >> 4, i = rho & 15; return 8 * (i >> 2) + 4 * n + (i & 3); }

struct Unit { int pm, pn; };
struct Gemm { const bf16_t* A; const bf16_t* Bt; int M, N, K, lda, agrp; };

struct StaticOrder {
    int nM, nN, nwg, G, c;
    __host__ __device__ void init(int M_, int N_, int G_, int c_) { nM = M_ / BM; nN = N_ / BM; nwg = nM * nN; G = G_; c = c_; }
    __host__ __device__ bool next(int i, Unit& u) const {
        const long L = (long)i * G + c; if (L >= nwg) return false;
        int wgid = (int)L; { const int q = nwg / NXCD, r = nwg % NXCD, xcd = wgid % NXCD, off = wgid / NXCD; wgid = (xcd < r ? xcd * (q + 1) : r * (q + 1) + (xcd - r) * q) + off; }
        const int nig = WGM * nN, gid = wgid / nig, fm = gid * WGM, gsz = (nM - fm) < WGM ? (nM - fm) : WGM;
        u.pm = fm + ((wgid % nig) % gsz); u.pn = (wgid % nig) / gsz; return true;
    }
    __device__ __forceinline__ void a_ready(const Unit&) const {}
    __device__ __forceinline__ void done(const Unit&) const {}
};

__device__ __forceinline__ unsigned cvt_pk_bf16(float lo, float hi) { unsigned r; asm volatile("v_cvt_pk_bf16_f32 %0, %1, %2" : "=v"(r) : "v"(lo), "v"(hi)); return r; }


struct EpiInEven {
    static constexpr bool PERM = true, AFTER_DRAIN = false;
    bf16_t* P; float* DT;
    __device__ __forceinline__ void operator()(const f32x4 (&acc)[2][2][4][2], const Unit& u, int wr, int wc, int fr, int fq) const {
        const int row0 = u.pm * BM + wr * 64 + fr;
        if (u.pn < 36) {
            const int mode = u.pn < 16 ? 0 : (u.pn < 24 ? 1 : 2);
            const int col0 = u.pn * BM + wc * 32 + 8 * fq;
#pragma unroll
            for (int ai = 0; ai < 2; ++ai)
#pragma unroll
                for (int m = 0; m < 4; ++m) { bf16_t* rowp = P + (size_t)(row0 + ai * HALF + m * 16) * PROJ_LD + col0;
#pragma unroll
                    for (int bj = 0; bj < 2; ++bj) { f32x4 v0 = acc[ai][bj][m][0], v1 = acc[ai][bj][m][1];
                        if (mode == 0) {
#pragma unroll
                            for (int j = 0; j < 4; ++j) { v0[j] = gelu_tanh_f(v0[j]); v1[j] = gelu_tanh_f(v1[j]); } }
                        else if (mode == 1) {
#pragma unroll
                            for (int j = 0; j < 4; ++j) { v0[j] = silu_f(v0[j]); v1[j] = silu_f(v1[j]); } }
                        v4u w; w.x = cvt_pk_bf16(v0[0], v0[1]); w.y = cvt_pk_bf16(v0[2], v0[3]); w.z = cvt_pk_bf16(v1[0], v1[1]); w.w = cvt_pk_bf16(v1[2], v1[3]);
                        *(v4u*)(rowp + bj * HALF) = w; } }
        } else if (wc < 2) {
#pragma unroll
            for (int ai = 0; ai < 2; ++ai)
#pragma unroll
                for (int m = 0; m < 4; ++m) { float* rp = DT + (size_t)(row0 + ai * HALF + m * 16) * 64 + wc * 32 + 8 * fq;
                    *(f32x4*)rp = acc[ai][0][m][0]; *(f32x4*)(rp + 4) = acc[ai][0][m][1]; }
        }
    }
};
struct EpiBf16 {
    static constexpr bool PERM = true, AFTER_DRAIN = false;
    bf16_t* O; int ldc; const float* scale;
    __device__ __forceinline__ void operator()(const f32x4 (&acc)[2][2][4][2], const Unit& u, int wr, int wc, int fr, int fq) const {
        const int row0 = u.pm * BM + wr * 64 + fr, col0 = u.pn * BM + wc * 32 + 8 * fq;
        f32x4 sv[2][2];
#pragma unroll
        for (int bj = 0; bj < 2; ++bj)
#pragma unroll
            for (int n = 0; n < 2; ++n) sv[bj][n] = scale ? *(const f32x4*)(scale + col0 + bj * HALF + 4 * n) : (f32x4){1.f, 1.f, 1.f, 1.f};
#pragma unroll
        for (int ai = 0; ai < 2; ++ai)
#pragma unroll
            for (int m = 0; m < 4; ++m) { bf16_t* rowp = O + (size_t)(row0 + ai * HALF + m * 16) * ldc + col0;
#pragma unroll
                for (int bj = 0; bj < 2; ++bj) { const f32x4 v0 = acc[ai][bj][m][0] * sv[bj][0], v1 = acc[ai][bj][m][1] * sv[bj][1];
                    v4u w; w.x = cvt_pk_bf16(v0[0], v0[1]); w.y = cvt_pk_bf16(v0[2], v0[3]); w.z = cvt_pk_bf16(v1[0], v1[1]); w.w = cvt_pk_bf16(v1[2], v1[3]);
                    *(v4u*)(rowp + bj * HALF) = w; } }
    }
};
struct EpiRes {
    static constexpr bool PERM = false, AFTER_DRAIN = false;
    const float* base_c; const float* base_s; float* X; const float* gate;
    __device__ __forceinline__ void operator()(const f32x4 (&acc)[2][2][4][2], const Unit& u, int wr, int wc, int fr, int fq) const {
        const int rowt = u.pm * BM, row0 = rowt + wr * 64 + fr, col0 = u.pn * BM + wc * 32 + 4 * fq;
        const float* g = gate + (size_t)cond_idx(rowt) * NMOD + col0;
        const float* bp = rowt < MC ? base_c + (size_t)row0 * D : base_s + (size_t)(row0 - MC) * D;
        f32x4 gv[2][2];
#pragma unroll
        for (int bj = 0; bj < 2; ++bj)
#pragma unroll
            for (int n = 0; n < 2; ++n) gv[bj][n] = *(const f32x4*)(g + bj * HALF + n * 16);
#pragma unroll
        for (int ai = 0; ai < 2; ++ai)
#pragma unroll
            for (int m = 0; m < 4; ++m) { const size_t ro = (size_t)(ai * HALF + m * 16) * D + col0; float* xo = X + (size_t)row0 * D + ro;
#pragma unroll
                for (int bj = 0; bj < 2; ++bj)
#pragma unroll
                    for (int n = 0; n < 2; ++n) { const f32x4 b = *(const f32x4*)(bp + ro + bj * HALF + n * 16);
                        *(f32x4*)(xo + bj * HALF + n * 16) = b + gv[bj][n] * acc[ai][bj][m][n]; }
                asm volatile("" ::: "memory"); }
    }
};
struct EpiFfnUp {
    static constexpr bool PERM = true, AFTER_DRAIN = false;
    bf16_t* G;
    __device__ __forceinline__ void operator()(const f32x4 (&acc)[2][2][4][2], const Unit& u, int wr, int wc, int fr, int fq) const {
        const int row0 = u.pm * BM + wr * 64 + fr, col0 = u.pn * HALF + wc * 32 + 8 * fq;
#pragma unroll
        for (int ai = 0; ai < 2; ++ai)
#pragma unroll
            for (int m = 0; m < 4; ++m) { bf16_t* rowp = G + (size_t)(row0 + ai * HALF + m * 16) * FF + col0;
                f32x4 v0, v1;
#pragma unroll
                for (int j = 0; j < 4; ++j) { v0[j] = silu_f(acc[ai][0][m][0][j]) * acc[ai][1][m][0][j]; v1[j] = silu_f(acc[ai][0][m][1][j]) * acc[ai][1][m][1][j]; }
                v4u w; w.x = cvt_pk_bf16(v0[0], v0[1]); w.y = cvt_pk_bf16(v0[2], v0[3]); w.z = cvt_pk_bf16(v1[0], v1[1]); w.w = cvt_pk_bf16(v1[2], v1[3]);
                *(v4u*)rowp = w; }
    }
};

template <class Epi, class Sched, bool ALIGN_EPI = false, bool SP2 = false>
__device__ __forceinline__ void gemm_phase(PG8_LAS unsigned char* lds, const Gemm g, const Sched& S, const Epi& E) {
    int tid = threadIdx.x; asm volatile("" : "+v"(tid));
    const int wid = __builtin_amdgcn_readfirstlane(tid >> 6), lane = tid & 63, wr = wid >> 2, wc = wid & 3, fr = lane & 15, fq = lane >> 4;
    const int K = g.K, nt = K / BK, lda = g.lda;
    unsigned voffA[2], voffB[2];
#pragma unroll
    for (int i = 0; i < 2; ++i) { int R, C; stage_rc(tid * 16 + i * 8192, R, C); const int Rb = Epi::PERM ? ((R & ~31) + perm32(R & 31)) : R;
        voffA[i] = (unsigned)(R * lda + C) * 2u; voffB[i] = (unsigned)(Rb * K + C) * 2u; }
    const size_t kstep = (size_t)(BK * 2);
    const size_t hstepA = (size_t)HALF * lda * 2, hstepB = (size_t)HALF * K * 2;
    const size_t tstepA = 2 * hstepA, tstepB = 2 * hstepB;
    const unsigned ldsw = (unsigned)wid * 1024u;
    const int aoff = lds_byte(wr * 64 + fr, fq * 8), boff = lds_byte(wc * 32 + fr, fq * 8);
#define PG8_SA(b, h) (((b) * 2 + (h)) * HTB)
#define PG8_SB(b, h) ((4 + (b) * 2 + (h)) * HTB)
#define PG8_STAGE(bufoff, gbase, voff) do { _Pragma("unroll") for (int _i = 0; _i < 2; ++_i) \
        __builtin_amdgcn_global_load_lds((const unsigned*)((const char*)(gbase) + (voff)[_i]), (PG8_LAS unsigned*)(lds + (bufoff) + ldsw + _i * 8192), 16, 0, 0); } while (0)
#define PG8_LDA(dst, b, h) do { _Pragma("unroll") for (int m = 0; m < 4; ++m) _Pragma("unroll") for (int k = 0; k < 2; ++k) dst[m][k] = *(const PG8_LAS bf16x8*)(lds + PG8_SA(b, h) + aoff + m * 2048 + k * 1024); } while (0)
#define PG8_LDB(dst, b, h) do { _Pragma("unroll") for (int n = 0; n < 2; ++n) _Pragma("unroll") for (int k = 0; k < 2; ++k) dst[n][k] = *(const PG8_LAS bf16x8*)(lds + PG8_SB(b, h) + boff + n * 2048 + k * 1024); } while (0)
#define PG8_MMA(ai, bj, At, Bt) do { __builtin_amdgcn_s_setprio(1); _Pragma("unroll") for (int m = 0; m < 4; ++m) _Pragma("unroll") for (int n = 0; n < 2; ++n) _Pragma("unroll") for (int k = 0; k < 2; ++k) \
        acc[ai][bj][m][n] = __builtin_amdgcn_mfma_f32_16x16x32_bf16(Bt[n][k], At[m][k], acc[ai][bj][m][n], 0, 0, 0); __builtin_amdgcn_s_setprio(0); } while (0)
#define PG8_WAIT_V(n) asm volatile("s_waitcnt vmcnt(" #n ")" ::: "memory")
#define PG8_WAIT_L(n) asm volatile("s_waitcnt lgkmcnt(" #n ")" ::: "memory")
#define PG8_BAR __builtin_amdgcn_s_barrier()
#define PG8_SCHED __builtin_amdgcn_sched_barrier(0)
#define PG8_ABASE(u) ((const char*)g.A + (size_t)(u).pm * tstepA + (g.agrp ? (size_t)((u).pn / g.agrp) * (size_t)K * 2 : (size_t)0))
    Unit cur, nxt; int ui = 0;
    if (!S.next(0, cur)) return;
    f32x4 acc[2][2][4][2];
#pragma unroll
    for (int a = 0; a < 2; ++a)
#pragma unroll
        for (int b = 0; b < 2; ++b)
#pragma unroll
            for (int m = 0; m < 4; ++m)
#pragma unroll
                for (int n = 0; n < 2; ++n) acc[a][b][m][n] = (f32x4){0.f, 0.f, 0.f, 0.f};
    bf16x8 At[4][2], B0[2][2], B1[2][2];
    const char* cA = PG8_ABASE(cur); const char* cB = (const char*)g.Bt + (size_t)cur.pn * tstepB;
    S.a_ready(cur);
    if constexpr (SP2) {
        PG8_STAGE(PG8_SB(0, 0), cB, voffB); PG8_STAGE(PG8_SB(0, 1), cB + hstepB, voffB); PG8_STAGE(PG8_SA(0, 0), cA, voffA); PG8_STAGE(PG8_SA(0, 1), cA + hstepA, voffA);
        if (wr == 1) PG8_BAR;
        PG8_WAIT_V(2); PG8_BAR;
        PG8_STAGE(PG8_SB(1, 0), cB + kstep, voffB); PG8_STAGE(PG8_SA(1, 0), cA + kstep, voffA); PG8_STAGE(PG8_SB(1, 1), cB + hstepB + kstep, voffB);
        PG8_WAIT_V(6); PG8_BAR;
    } else {
        PG8_STAGE(PG8_SB(0, 0), cB, voffB); PG8_STAGE(PG8_SA(0, 0), cA, voffA); PG8_STAGE(PG8_SB(0, 1), cB + hstepB, voffB); PG8_STAGE(PG8_SA(0, 1), cA + hstepA, voffA);
        if (wr == 1) PG8_BAR;
        PG8_WAIT_V(4); PG8_BAR;
        PG8_STAGE(PG8_SB(1, 0), cB + kstep, voffB); PG8_STAGE(PG8_SA(1, 0), cA + kstep, voffA); PG8_STAGE(PG8_SB(1, 1), cB + hstepB + kstep, voffB);
        PG8_WAIT_V(6); PG8_BAR;
    }
    for (;;) {
        const bool has_next = S.next(ui + 1, nxt);
        const char* nA = has_next ? PG8_ABASE(nxt) : cA; const char* nB = has_next ? (const char*)g.Bt + (size_t)nxt.pn * tstepB : cB;
        for (int t = 0; t < nt; t += 2) {
            const bool last = (t == nt - 2);
            const char* a1 = cA + (size_t)(t + 1) * kstep;
            const char* a2 = last ? nA : cA + (size_t)(t + 2) * kstep; const char* b2 = last ? nB : cB + (size_t)(t + 2) * kstep;
            const char* a3 = a2 + kstep; const char* b3 = b2 + kstep;
            if (last && has_next) S.a_ready(nxt);
            if constexpr (SP2) {
            PG8_LDB(B0, 0, 0); PG8_LDB(B1, 0, 1); PG8_SCHED; PG8_LDA(At, 0, 0); PG8_STAGE(PG8_SA(1, 1), a1 + hstepA, voffA);
            PG8_WAIT_V(8); PG8_WAIT_L(0); PG8_BAR; PG8_MMA(0, 0, At, B0); PG8_MMA(0, 1, At, B1); PG8_BAR; PG8_SCHED;
            PG8_LDA(At, 0, 1); PG8_STAGE(PG8_SB(0, 0), b2, voffB); PG8_STAGE(PG8_SB(0, 1), b2 + hstepB, voffB); PG8_STAGE(PG8_SA(0, 0), a2, voffA);
            PG8_WAIT_V(8); PG8_WAIT_L(0); PG8_BAR; PG8_MMA(1, 0, At, B0); PG8_MMA(1, 1, At, B1); PG8_BAR; PG8_SCHED;
            PG8_LDB(B0, 1, 0); PG8_LDB(B1, 1, 1); PG8_SCHED; PG8_LDA(At, 1, 0); PG8_STAGE(PG8_SA(0, 1), a2 + hstepA, voffA);
            PG8_WAIT_V(8); PG8_WAIT_L(0); PG8_BAR; PG8_MMA(0, 0, At, B0); PG8_MMA(0, 1, At, B1); PG8_BAR; PG8_SCHED;
            PG8_LDA(At, 1, 1); PG8_STAGE(PG8_SB(1, 0), b3, voffB); PG8_STAGE(PG8_SB(1, 1), b3 + hstepB, voffB); PG8_STAGE(PG8_SA(1, 0), a3, voffA);
            PG8_WAIT_V(8); PG8_WAIT_L(0); PG8_BAR; PG8_MMA(1, 0, At, B0); PG8_MMA(1, 1, At, B1); PG8_BAR; PG8_SCHED;
            } else {
            PG8_LDB(B0, 0, 0); PG8_SCHED; PG8_LDA(At, 0, 0); PG8_STAGE(PG8_SA(1, 1), a1 + hstepA, voffA);
            PG8_WAIT_L(8); PG8_BAR; PG8_WAIT_L(0); PG8_MMA(0, 0, At, B0); PG8_BAR; PG8_SCHED;
            PG8_LDB(B1, 0, 1); PG8_STAGE(PG8_SB(0, 0), b2, voffB);
            PG8_BAR; PG8_WAIT_L(0); PG8_MMA(0, 1, At, B1); PG8_BAR;
            PG8_LDA(At, 0, 1); PG8_STAGE(PG8_SA(0, 0), a2, voffA);
            PG8_BAR; PG8_WAIT_L(0); PG8_MMA(1, 0, At, B0); PG8_BAR; PG8_SCHED;
            PG8_STAGE(PG8_SB(0, 1), b2 + hstepB, voffB);
            PG8_WAIT_V(6); PG8_BAR; PG8_MMA(1, 1, At, B1); PG8_BAR;
            PG8_LDB(B0, 1, 0); PG8_SCHED; PG8_LDA(At, 1, 0); PG8_STAGE(PG8_SA(0, 1), a2 + hstepA, voffA);
            PG8_WAIT_L(8); PG8_BAR; PG8_WAIT_L(0); PG8_MMA(0, 0, At, B0); PG8_BAR; PG8_SCHED;
            PG8_LDB(B1, 1, 1); PG8_STAGE(PG8_SB(1, 0), b3, voffB);
            PG8_BAR; PG8_WAIT_L(0); PG8_MMA(0, 1, At, B1); PG8_BAR;
            PG8_LDA(At, 1, 1); PG8_STAGE(PG8_SA(1, 0), a3, voffA);
            PG8_BAR; PG8_WAIT_L(0); PG8_MMA(1, 0, At, B0); PG8_BAR; PG8_SCHED;
            PG8_STAGE(PG8_SB(1, 1), b3 + hstepB, voffB);
            PG8_WAIT_V(6); PG8_BAR; PG8_MMA(1, 1, At, B1); PG8_BAR;
            }
        }
        if constexpr (ALIGN_EPI) { if (wr == 0) PG8_BAR; }
        if constexpr (!Epi::AFTER_DRAIN) { E(acc, cur, wr, wc, fr, fq); S.done(cur); }
        if (!has_next) break;
#pragma unroll
        for (int a = 0; a < 2; ++a)
#pragma unroll
            for (int b = 0; b < 2; ++b)
#pragma unroll
                for (int m = 0; m < 4; ++m)
#pragma unroll
                    for (int n = 0; n < 2; ++n) acc[a][b][m][n] = (f32x4){0.f, 0.f, 0.f, 0.f};
        cur = nxt; cA = nA; cB = nB; ++ui;
        if constexpr (ALIGN_EPI) { if (wr == 1) PG8_BAR; }
    }
    PG8_WAIT_V(0);
    if constexpr (!ALIGN_EPI) { if (wr == 0) PG8_BAR; }
    PG8_BAR;
#undef PG8_SA
#undef PG8_SB
#undef PG8_STAGE
#undef PG8_LDA
#undef PG8_LDB
#undef PG8_MMA
#undef PG8_WAIT_V
#undef PG8_WAIT_L
#undef PG8_BAR
#undef PG8_SCHED
#undef PG8_ABASE
}
}

#define XB_TMO      128
#define XB_XCNT(j)  (256  + 64 * (j))
#define XB_XSUB(j)  (1280 + 64 * (j))
#define XB_XGEN(j)  (2304 + 64 * (j))
#define XB_TOP      3328
#define XB_TOPGEN   3392
#define XCD_BAR_WORDS 3456
#define XB_SPIN_CAP (1u << 18)
__device__ __forceinline__ unsigned xb_ld(unsigned* p)              { return __hip_atomic_load(p, __ATOMIC_RELAXED, __HIP_MEMORY_SCOPE_AGENT); }
__device__ __forceinline__ unsigned xb_add(unsigned* p, unsigned v) { return __hip_atomic_fetch_add(p, v, __ATOMIC_RELAXED, __HIP_MEMORY_SCOPE_AGENT); }
__device__ __forceinline__ unsigned xb_xcc_id() { return (unsigned)__builtin_amdgcn_s_getreg((3 << 11) | 20) & 0xFu; }
#define XB_SPIN(cond, bar) do { unsigned _sp = 0; while (cond) { __builtin_amdgcn_s_sleep(1); \
    if ((++_sp & 255u) == 0u) { if (xb_ld(&(bar)[XB_TMO])) break; if (_sp > XB_SPIN_CAP) { atomicAdd(&(bar)[XB_TMO], 1u); break; } } } } while (0)
struct XcdBarrier { unsigned* bar; unsigned x; volatile LAS unsigned* st; };
__device__ __forceinline__ XcdBarrier xcd_barrier_post(unsigned* bar, volatile LAS unsigned* st) {
    XcdBarrier b; b.bar = bar; b.x = xb_xcc_id(); b.st = st;
    if (threadIdx.x == 0) (void)xb_add(&bar[XB_XCNT(b.x)], 1u);
    return b;
}
__device__ __forceinline__ void xcd_barrier_complete(unsigned* bar, unsigned x, unsigned& nloc, unsigned& nx) {
    const unsigned G = gridDim.x * gridDim.y * gridDim.z;
    unsigned sum, cnt, mine, sp = 0u;
    for (;;) {
        sum = 0u; cnt = 0u; mine = 0u;
#pragma unroll
        for (unsigned j = 0; j < 16; ++j) { const unsigned c = xb_ld(&bar[XB_XCNT(j)]); sum += c; cnt += (c > 0u) ? 1u : 0u; mine = (j == x) ? c : mine; }
        if (sum == G) break;
        __builtin_amdgcn_s_sleep(1);
        if ((++sp & 255u) == 0u) { if (xb_ld(&bar[XB_TMO])) break; if (sp > XB_SPIN_CAP) { atomicAdd(&bar[XB_TMO], 1u); break; } }
    }
    nloc = mine > 0u ? mine : 1u; nx = cnt > 0u ? cnt : 1u;
}
__device__ __forceinline__ void xcd_barrier(const XcdBarrier& b) {
    asm volatile("s_waitcnt vmcnt(0)" ::: "memory");
    __syncthreads();
    if (threadIdx.x == 0) {
        unsigned* bar = b.bar;
        __builtin_amdgcn_s_waitcnt(0);
        unsigned nloc = b.st[0], nx = b.st[1];
        if (nloc == 0u) { xcd_barrier_complete(bar, b.x, nloc, nx); b.st[0] = nloc; b.st[1] = nx; }
        const unsigned old = xb_add(&bar[XB_XSUB(b.x)], 1u);
        const unsigned gen = old / nloc;
        if (old + 1u == (gen + 1u) * nloc) {
            __builtin_amdgcn_fence(__ATOMIC_RELEASE, "agent");
            asm volatile("s_waitcnt vmcnt(0)" ::: "memory");
            const unsigned og = xb_add(&bar[XB_TOP], 1u);
            const unsigned tg = og / nx;
            if (og + 1u == (tg + 1u) * nx) xb_add(&bar[XB_TOPGEN], 1u);
            else XB_SPIN(xb_ld(&bar[XB_TOPGEN]) == tg, bar);
            __builtin_amdgcn_fence(__ATOMIC_ACQUIRE, "agent");
            xb_add(&bar[XB_XGEN(b.x)], 1u);
            asm volatile("s_waitcnt vmcnt(0)" ::: "memory");
        } else {
            XB_SPIN(xb_ld(&bar[XB_XGEN(b.x)]) == gen, bar);
            __builtin_amdgcn_fence(__ATOMIC_ACQUIRE, "agent");
            asm volatile("s_waitcnt vmcnt(0)" ::: "memory");
        }
    }
    __syncthreads();
}

struct Args {
    const float* in[28]; float* out; unsigned char* ws; int ph_lo, ph_hi, li, pad;
};
enum { I_XP = 0, I_XS, I_STATE, I_C, I_CCTX, I_WMOD, I_BMOD, I_NMIX, I_NFFN, I_WINE, I_WOUTE, I_GNORM, I_GWS, I_GBS, I_CONVW, I_CONVB,
       I_DTB, I_ALOG, I_SSDD, I_SNORM, I_WINO, I_POOLW, I_PSCALE, I_WOUTO, I_W1, I_W3, I_W2, I_FNORM };

typedef __attribute__((address_space(4))) const Args CArgs;
__device__ __forceinline__ CArgs* kargs(int salt) { CArgs* p = (CArgs*)__builtin_amdgcn_kernarg_segment_ptr(); asm volatile("" : "+s"(p) : "s"(salt)); return p; }

__device__ __forceinline__ void transpose_item(const float* W, int ldw, int k0, int n0, bf16* WT, int K, int drow0, LAS float* scr, int lane) {
    constexpr int PT = 65;
    const int lr = lane >> 4, lc = 4 * (lane & 15);
    f32x4 v[16];
#pragma unroll
    for (int i = 0; i < 16; ++i) v[i] = *(const f32x4*)(W + (size_t)(k0 + 4 * i + lr) * ldw + n0 + lc);
#pragma unroll
    for (int i = 0; i < 16; ++i) { LAS float* s = scr + (4 * i + lr) * PT + lc; s[0] = v[i][0]; s[1] = v[i][1]; s[2] = v[i][2]; s[3] = v[i][3]; }
    LDS_WAIT(); asm volatile("" ::: "memory");
    const int c = lane & 7;
#pragma unroll
    for (int j = 0; j < 8; ++j) { const int n = (lane >> 3) + 8 * j; const LAS float* s = scr + (8 * c) * PT + n;
        v4u o; o.x = pk2(s[0 * PT], s[1 * PT]); o.y = pk2(s[2 * PT], s[3 * PT]); o.z = pk2(s[4 * PT], s[5 * PT]); o.w = pk2(s[6 * PT], s[7 * PT]);
        *(v4u*)(WT + (size_t)(drow0 + n) * K + k0 + 8 * c) = o; }
    LDS_WAIT(); asm volatile("" ::: "memory");
}

struct Frame {
    LAS unsigned char* lds;
    volatile LAS unsigned* MISC;
    unsigned* ctl;
    int tid, lane, wave, G, bid;
    float* out; unsigned char* ws;
};

__device__ __forceinline__ Frame mkframe(CArgs* A) {
    extern __shared__ __attribute__((aligned(16))) unsigned char lds_base[];
    Frame F; int t = threadIdx.x; asm volatile("" : "+v"(t));
    F.lds = (LAS unsigned char*)lds_base; F.MISC = (volatile LAS unsigned*)(F.lds + MISC_OFF);
    F.tid = t; F.lane = t & 63; F.wave = __builtin_amdgcn_readfirstlane(t >> 6);
    int g = gridDim.x, b = blockIdx.x; asm volatile("" : "+s"(g), "+s"(b));
    F.G = g; F.bid = b; F.out = A->out; F.ws = A->ws; F.ctl = (unsigned*)(A->ws + WS_CTL);
    return F;
}
__device__ __forceinline__ void p0_prologue(Frame& F, CArgs& args) {
    {
        LAS float* sc = (LAS float*)F.lds;
        LAS float* red = (LAS float*)(F.lds + 5 * D * 4);
        for (int i = F.tid; i < 5 * D; i += NTHR) { const int r = i / D, k = i % D; const float c = r < 4 ? args.in[I_C][r * D + k] : args.in[I_CCTX][k]; sc[i] = silu_f(c); }
        __syncthreads();
        float* MOD = (float*)(F.ws + WS_MOD);
        for (int u = F.bid; u < 4 * 96; u += F.G) {
            const int l = u / 96, j0 = (u % 96) * 128 + 2 * F.lane;
            const float* w = args.in[I_WMOD] + ((size_t)l * D + (size_t)F.wave * 256) * NMOD + j0;
            float a[5][2];
#pragma unroll
            for (int r = 0; r < 5; ++r) { a[r][0] = 0.f; a[r][1] = 0.f; }
#pragma unroll 8
            for (int k = 0; k < 256; ++k) { const f32x2 wv = *(const f32x2*)(w + (size_t)k * NMOD);
#pragma unroll
                for (int r = 0; r < 5; ++r) { const float s = sc[r * D + F.wave * 256 + k]; a[r][0] += s * wv.x; a[r][1] += s * wv.y; } }
#pragma unroll
            for (int r = 0; r < 5; ++r) { red[(F.wave * 5 + r) * 128 + 2 * F.lane] = a[r][0]; red[(F.wave * 5 + r) * 128 + 2 * F.lane + 1] = a[r][1]; }
            __syncthreads();
            for (int i = F.tid; i < 5 * 128; i += NTHR) { const int r = i >> 7, j = i & 127; float s = args.in[I_BMOD][l * NMOD + (u % 96) * 128 + j];
#pragma unroll
                for (int w8 = 0; w8 < 8; ++w8) s += red[(w8 * 5 + r) * 128 + j];
                MOD[((size_t)l * 5 + r) * NMOD + (u % 96) * 128 + j] = s; }
            __syncthreads();
        }
    }
    __syncthreads();
    {
        LAS float* scr = (LAS float*)(F.lds + F.wave * 16896);
        const int gw = F.bid * NWAVES + F.wave, NGW = F.G * NWAVES;
        constexpr int I_INE = 2 * 32 * 145, I_OUTE = 2 * 64 * 32, I_INO = 2 * 32 * 32, I_OUTO = 2 * 32 * 32, I_PW = 8 * 8 * 8, I_UP = 8 * 32 * 88, I_DN = 4 * 88 * 32;
        constexpr int NITEMS = I_INE + I_OUTE + I_INO + I_OUTO + I_PW + I_UP + I_DN;
        for (int it = gw; it < NITEMS; it += NGW) {
            int r = it;
            if (r < I_INE) { const int e = r / (32 * 145), q = r % (32 * 145), kb = q / 145, nb = q % 145;
                transpose_item(args.in[I_WINE] + (size_t)e * D * IN_EVEN, IN_EVEN, 64 * kb, 64 * nb, (bf16*)(F.ws + WS_WINE) + (size_t)e * IN_PAD * D, D, 64 * nb, scr, F.lane); continue; }
            r -= I_INE;
            if (r < I_OUTE) { const int e = r / (64 * 32), q = r % (64 * 32), kb = q / 32, nb = q % 32;
                transpose_item(args.in[I_WOUTE] + (size_t)e * 4096 * D, D, 64 * kb, 64 * nb, (bf16*)(F.ws + WS_WOUTE) + (size_t)e * D * 4096, 4096, 64 * nb, scr, F.lane); continue; }
            r -= I_OUTE;
            if (r < I_INO) { const int o = r / 1024, q = r % 1024, kb = q / 32, nb = q % 32;
                transpose_item(args.in[I_WINO] + (size_t)o * D * D, D, 64 * kb, 64 * nb, (bf16*)(F.ws + WS_WINO) + (size_t)o * D * D, D, 64 * nb, scr, F.lane); continue; }
            r -= I_INO;
            if (r < I_OUTO) { const int o = r / 1024, q = r % 1024, kb = q / 32, nb = q % 32;
                transpose_item(args.in[I_WOUTO] + (size_t)o * D * D, D, 64 * kb, 64 * nb, (bf16*)(F.ws + WS_WOUTO) + (size_t)o * D * D, D, 64 * nb, scr, F.lane); continue; }
            r -= I_OUTO;
            if (r < I_PW) { const int og = r / 64, q = r % 64, kb = q / 8, nb = q % 8, o = og / 4, gg = og % 4;
                transpose_item(args.in[I_POOLW] + (size_t)og * 512 * 512, 512, 64 * kb, 64 * nb, (bf16*)(F.ws + WS_WPOOL) + (size_t)o * D * 512, 512, gg * 512 + 64 * nb, scr, F.lane); continue; }
            r -= I_PW;
            if (r < I_UP) { const int lw = r / (32 * 88), q = r % (32 * 88), kb = q / 88, nb = q % 88, l = lw >> 1, w3 = lw & 1; const int n0 = 64 * nb;
                transpose_item((w3 ? args.in[I_W3] : args.in[I_W1]) + (size_t)l * D * FF, FF, 64 * kb, n0, (bf16*)(F.ws + WS_WUP) + (size_t)l * NFU * D, D, 256 * (n0 >> 7) + (n0 & 127) + (w3 ? 128 : 0), scr, F.lane); continue; }
            r -= I_UP;
            { const int l = r / (88 * 32), q = r % (88 * 32), kb = q / 32, nb = q % 32;
                transpose_item(args.in[I_W2] + (size_t)l * FF * D, D, 64 * kb, 64 * nb, (bf16*)(F.ws + WS_WDN) + (size_t)l * D * FF, FF, 64 * nb, scr, F.lane); }
        }
    }
}

__device__ __forceinline__ void norm_phase(Frame& F, const float* xc, const float* xs, const float* w, const float* modl, int shc, bf16* H) {
    const int gw = F.bid * NWAVES + F.wave, NGW = F.G * NWAVES;
    for (int row = gw; row < M; row += NGW) {
        const float* xr = row < MC ? xc + (size_t)row * D : xs + (size_t)(row - MC) * D;
        const float* mr = modl + (size_t)cond_idx(row) * NMOD + shc * D;
        f32x4 v[8]; float s = 0.f;
#pragma unroll
        for (int j = 0; j < 8; ++j) { v[j] = *(const f32x4*)(xr + 4 * F.lane + 256 * j); s += (v[j].x * v[j].x + v[j].y * v[j].y) + (v[j].z * v[j].z + v[j].w * v[j].w); }
        const float rstd = 1.0f / sqrtf(wave_sum(s) * (1.0f / D) + EPS);
#pragma unroll
        for (int j = 0; j < 8; ++j) { const int c = 4 * F.lane + 256 * j;
            const f32x4 wv = *(const f32x4*)(w + c), sh = *(const f32x4*)(mr + c), sc = *(const f32x4*)(mr + D + c);
            const f32x4 y = v[j] * rstd * wv * (sc + 1.0f) + sh;
            v2u o; o.x = pk2(y.x, y.y); o.y = pk2(y.z, y.w);
            *(v2u*)(H + (size_t)row * D + c) = o; }
    }
}
__device__ __forceinline__ void final_norm_phase(Frame& F, const float* X, const float* w, float* out) {
    const int gw = F.bid * NWAVES + F.wave, NGW = F.G * NWAVES;
    for (int row = gw; row < M; row += NGW) {
        const float* xr = X + (size_t)row * D;
        f32x4 v[8]; float s = 0.f;
#pragma unroll
        for (int j = 0; j < 8; ++j) { v[j] = *(const f32x4*)(xr + 4 * F.lane + 256 * j); s += (v[j].x * v[j].x + v[j].y * v[j].y) + (v[j].z * v[j].z + v[j].w * v[j].w); }
        const float rstd = 1.0f / sqrtf(wave_sum(s) * (1.0f / D) + EPS);
#pragma unroll
        for (int j = 0; j < 8; ++j) { const int c = 4 * F.lane + 256 * j; const f32x4 wv = *(const f32x4*)(w + c);
            *(f32x4*)(out + (size_t)row * D + c) = v[j] * rstd * wv; }
    }
}

__device__ __forceinline__ void gmlp_unit_naive(Frame& F, int chunk, int g, const bf16* PROJ, const float* vnorm, const float* ws, const float* bs, bf16* AB) {
    LAS float* sv = (LAS float*)F.lds;
    LAS float* srs = (LAS float*)(F.lds + 131072);
    const int row0 = chunk * 128;
    for (int i = F.tid; i < 128 * 256; i += NTHR) { const int s = i >> 8, ch = i & 255; sv[i] = bf2f(PROJ[(size_t)(row0 + s) * PROJ_LD + 2048 + g * 256 + ch]); }
    __syncthreads();
    if (F.tid < 128) { float q = 0.f; for (int ch = 0; ch < 256; ++ch) { const float v = sv[F.tid * 256 + ((ch + F.tid) & 255)]; q += v * v; } srs[F.tid] = 1.0f / sqrtf(q * (1.0f / 256.f) + EPS); }
    __syncthreads();
    for (int i = F.tid; i < 128 * 256; i += NTHR) { const int s = i >> 8, ch = i & 255; sv[i] = sv[i] * srs[s] * vnorm[g * 256 + ch]; }
    __syncthreads();
    const int ch = F.tid & 255, th = F.tid >> 8;
    for (int tt = 0; tt < 64; ++tt) { const int t = th * 64 + tt; const float* wr = ws + ((size_t)g * 128 + t) * 128; float a = 0.f;
#pragma unroll 8
        for (int s = 0; s < 128; ++s) a += wr[s] * sv[s * 256 + ch];
        a += bs[g * 128 + t];
        const float uu = bf2f(PROJ[(size_t)(row0 + t) * PROJ_LD + g * 256 + ch]);
        AB[(size_t)(row0 + t) * 4096 + g * 256 + ch] = (bf16)f2bf(uu * a); }
    __syncthreads();
}

__device__ __forceinline__ void ssd_unit_naive(Frame& F, int seq_row0, int L, int head, int dir, const float* h0  , float* hfin  ,
                                               const bf16* PROJ, const float* DT, const float* convw, const float* convb, float dtbias, float alog, float dskip, bf16* Y) {
    LAS float* sB = (LAS float*)F.lds; LAS float* sC = sB + 128; LAS float* sX = sC + 128; LAS float* sdt = sX + 64;
    const int p = F.tid >> 3, ng = F.tid & 7;
    float h[16];
#pragma unroll
    for (int j = 0; j < 16; ++j) h[j] = h0 ? h0[p * 128 + 16 * ng + j] : 0.f;
    const float negA = -__expf(alog);
    int ch = -1;
    if (F.tid < 128) ch = 2048 + (head >> 3) * 128 + F.tid;
    else if (F.tid < 256) ch = 2560 + (head >> 3) * 128 + (F.tid - 128);
    else if (F.tid < 320) ch = head * 64 + (F.tid - 256);
    float cw[5] = {0.f, 0.f, 0.f, 0.f, 0.f}, cb = 0.f;
    if (ch >= 0) {
#pragma unroll
        for (int k = 0; k < 5; ++k) cw[k] = convw[k * CCONV + ch];
        cb = convb[ch]; }
    for (int step = 0; step < L; ++step) {
        const int t = dir ? (L - 1 - step) : step;
        if (ch >= 0) { float a = cb;
#pragma unroll
            for (int k = 0; k < 5; ++k) { const int tt = t + k - 2; if (tt >= 0 && tt < L) a += cw[k] * bf2f(PROJ[(size_t)(seq_row0 + tt) * PROJ_LD + 6144 + ch]); }
            a = silu_f(a);
            if (F.tid < 128) sB[F.tid] = a; else if (F.tid < 256) sC[F.tid - 128] = a; else sX[F.tid - 256] = a; }
        if (F.tid == 320) sdt[0] = softplus_f(DT[(size_t)(seq_row0 + t) * 64 + dir * 32 + head] + dtbias);
        __syncthreads();
        const float dt = sdt[0], dec = __expf(negA * dt), xs = sX[p], xg = xs * dt;
        float part = 0.f;
#pragma unroll
        for (int j = 0; j < 16; ++j) { h[j] = dec * h[j] + xg * sB[16 * ng + j]; part += h[j] * sC[16 * ng + j]; }
        part += __shfl_xor(part, 1); part += __shfl_xor(part, 2); part += __shfl_xor(part, 4);
        if (ng == 0) { if (dir == 0) part += dskip * xs; Y[(size_t)(seq_row0 + t) * D + head * 64 + p] = (bf16)f2bf(part); }
        __syncthreads();
    }
    if (hfin) {
#pragma unroll
        for (int j = 0; j < 16; ++j) hfin[p * 128 + 16 * ng + j] = h[j]; }
}

__device__ __forceinline__ void ssd_combine_phase(Frame& F, const bf16* YF, const bf16* YB, const bf16* PROJ, const float* nw, bf16* AB) {
    const int gw = F.bid * NWAVES + F.wave, NGW = F.G * NWAVES;
    for (int row = gw; row < M; row += NGW) {
        float y[32]; float s = 0.f;
#pragma unroll
        for (int j = 0; j < 4; ++j) { const int c = 8 * F.lane + 512 * j;
            const v4u a = *(const v4u*)(YF + (size_t)row * D + c), b = *(const v4u*)(YB + (size_t)row * D + c), z = *(const v4u*)(PROJ + (size_t)row * PROJ_LD + 4096 + c);
#pragma unroll
            for (int q = 0; q < 4; ++q) { const float lo = (bflo(a[q]) + bflo(b[q])) * bflo(z[q]), hi = (bfhi(a[q]) + bfhi(b[q])) * bfhi(z[q]);
                y[8 * j + 2 * q] = lo; y[8 * j + 2 * q + 1] = hi; s += lo * lo + hi * hi; } }
        const float rstd = 1.0f / sqrtf(wave_sum(s) * (1.0f / D) + EPS);
#pragma unroll
        for (int j = 0; j < 4; ++j) { const int c = 8 * F.lane + 512 * j; const f32x4 w0 = *(const f32x4*)(nw + c), w1 = *(const f32x4*)(nw + c + 4);
            v4u o; o.x = pk2(y[8 * j] * rstd * w0.x, y[8 * j + 1] * rstd * w0.y); o.y = pk2(y[8 * j + 2] * rstd * w0.z, y[8 * j + 3] * rstd * w0.w);
            o.z = pk2(y[8 * j + 4] * rstd * w1.x, y[8 * j + 5] * rstd * w1.y); o.w = pk2(y[8 * j + 6] * rstd * w1.z, y[8 * j + 7] * rstd * w1.w);
            *(v4u*)(AB + (size_t)row * 4096 + 2048 + c) = o; }
    }
}

__device__ __forceinline__ void pool_phase(Frame& F, const bf16* HC, bf16* PL) {
    const size_t nth = (size_t)F.G * NTHR;
    for (size_t i = (size_t)F.bid * NTHR + F.tid; i < (size_t)M * 256; i += nth) {
        const int row = (int)(i >> 8), c = (int)(i & 255) * 8, g = c >> 9, k = 2 << g;
        int a0, W;
        if (row < MC) { a0 = row & ~255; W = 256; } else { a0 = row & ~63; W = 64; }
        const int t = row - a0; int lo = t - k / 2; if (lo < 0) lo = 0; int hi = t - k / 2 + k; if (hi > W) hi = W;
        float s[8] = {0.f, 0.f, 0.f, 0.f, 0.f, 0.f, 0.f, 0.f};
        for (int r = lo; r < hi; ++r) { const v4u v = *(const v4u*)(HC + (size_t)(a0 + r) * D + c);
#pragma unroll
            for (int q = 0; q < 4; ++q) { s[2 * q] += bflo(v[q]); s[2 * q + 1] += bfhi(v[q]); } }
        const float inv = 1.0f / (float)(hi - lo);
        const v4u x = *(const v4u*)(HC + (size_t)row * D + c);
        v4u o;
#pragma unroll
        for (int q = 0; q < 4; ++q) o[q] = pk2(s[2 * q] * inv - bflo(x[q]), s[2 * q + 1] * inv - bfhi(x[q]));
        *(v4u*)(PL + (size_t)row * D + c) = o;
    }
}

constexpr int NPHASES = 34;
#define WSP(T, off) ((T*)(ws + (off)))
__global__ void __launch_bounds__(NTHR, 2) mega_fwd(Args args_by_value) {
    extern __shared__ __attribute__((aligned(16))) unsigned char lds[];
    int lo, hi;
    XcdBarrier bar;
    { CArgs* A = kargs(0); lo = A->ph_lo; hi = A->ph_hi;
      if (threadIdx.x < 64) ((LAS unsigned*)((LAS unsigned char*)lds + MISC_OFF))[threadIdx.x] = 0u;
      __syncthreads();
      bar = xcd_barrier_post((unsigned*)(A->ws + WS_CTL) + CW_BAR + A->li * XCD_BAR_WORDS, (volatile LAS unsigned*)((LAS unsigned char*)lds + MISC_OFF) + 8); }
#define IN(k) (lo <= (k) && (k) < hi)
#define SEAM(k) do { if (IN((k) + 1)) xcd_barrier(bar); } while (0)

    if (IN(0)) { CArgs* A = kargs(0); Frame F = mkframe(A); p0_prologue(F, *A); SEAM(0); }

    for (int l = 0; l < DEPTH; ++l) {
        const int pb = 1 + 8 * l, e = l >> 1;
        if (IN(pb + 0)) { CArgs* A = kargs(pb); Frame F = mkframe(A); unsigned char* ws = A->ws; float* X = WSP(float, WS_X);
            norm_phase(F, l == 0 ? A->in[I_XP] : X, l == 0 ? A->in[I_XS] : X + (size_t)MC * D, A->in[I_NMIX] + l * D, WSP(const float, WS_MOD) + (size_t)l * 5 * NMOD, 0, WSP(bf16, WS_H)); SEAM(pb + 0); }
        if ((l & 1) == 0) {
            if (IN(pb + 1)) { CArgs* A = kargs(pb + 1); Frame F = mkframe(A); unsigned char* ws = A->ws;
                pg8::Gemm g{WSP(bf16, WS_H), WSP(const bf16, WS_WINE) + (size_t)e * IN_PAD * D, M, IN_PAD, D, D, 0}; pg8::StaticOrder S; S.init(M, IN_PAD, F.G, F.bid);
                pg8::EpiInEven E{WSP(bf16, WS_PROJ), WSP(float, WS_DT)};
                pg8::gemm_phase<pg8::EpiInEven, pg8::StaticOrder, true, true>(F.lds, g, S, E);
                SEAM(pb + 1);
            }
            if (IN(pb + 2)) {
                for (int u = blockIdx.x; u < 3840; u += gridDim.x) { CArgs* A = kargs(u); Frame F = mkframe(A); unsigned char* ws = A->ws;
                    if (u < 2304) {
                        int seq0, L, b, head, dir; const float* h0 = nullptr; float* hf = nullptr;
                        if (u < 256) { b = u >> 6; head = (u >> 1) & 31; dir = u & 1; seq0 = MC + b * SEQ_S; L = SEQ_S;
                            h0 = A->in[I_STATE] + ((((size_t)b * 2 + e) * 2 + dir) * NH + head) * (HP * NST); }
                        else { const int v = u - 256; b = v >> 6; head = (v >> 1) & 31; dir = v & 1; seq0 = b * SEQ_C; L = SEQ_C;
                            hf = A->out + (size_t)M * D + ((((size_t)b * 2 + e) * 2 + dir) * NH + head) * (HP * NST); }
                        ssd_unit_naive(F, seq0, L, head, dir, h0, hf, WSP(const bf16, WS_PROJ), WSP(const float, WS_DT), A->in[I_CONVW] + (size_t)e * 5 * CCONV, A->in[I_CONVB] + (size_t)e * CCONV,
                                       A->in[I_DTB][(e * 2 + dir) * NH + head], A->in[I_ALOG][(e * 2 + dir) * NH + head], A->in[I_SSDD][e * NH + head], dir ? WSP(bf16, WS_YB) : WSP(bf16, WS_YF));
                    } else { const int v = u - 2304;
                        gmlp_unit_naive(F, v >> 3, v & 7, WSP(const bf16, WS_PROJ), A->in[I_GNORM] + e * D, A->in[I_GWS] + (size_t)e * 8 * 128 * 128, A->in[I_GBS] + e * 8 * 128, WSP(bf16, WS_AB)); }
                }
                SEAM(pb + 2);
            }
            if (IN(pb + 3)) { CArgs* A = kargs(pb + 3); Frame F = mkframe(A); unsigned char* ws = A->ws;
                ssd_combine_phase(F, WSP(const bf16, WS_YF), WSP(const bf16, WS_YB), WSP(const bf16, WS_PROJ), A->in[I_SNORM] + e * D, WSP(bf16, WS_AB)); SEAM(pb + 3); }
        } else {
            if (IN(pb + 1)) { CArgs* A = kargs(pb + 1); Frame F = mkframe(A); unsigned char* ws = A->ws;
                pg8::Gemm g{WSP(bf16, WS_H), WSP(const bf16, WS_WINO) + (size_t)e * D * D, M, D, D, D, 0}; pg8::StaticOrder S; S.init(M, D, F.G, F.bid);
                pg8::EpiBf16 E{WSP(bf16, WS_HC), D, nullptr};
                pg8::gemm_phase<pg8::EpiBf16, pg8::StaticOrder, true, true>(F.lds, g, S, E);
                SEAM(pb + 1);
            }
            if (IN(pb + 2)) { CArgs* A = kargs(pb + 2); Frame F = mkframe(A); unsigned char* ws = A->ws; pool_phase(F, WSP(const bf16, WS_HC), WSP(bf16, WS_PL)); SEAM(pb + 2); }
            if (IN(pb + 3)) { CArgs* A = kargs(pb + 3); Frame F = mkframe(A); unsigned char* ws = A->ws;
                pg8::Gemm g{WSP(bf16, WS_PL), WSP(const bf16, WS_WPOOL) + (size_t)e * D * 512, M, D, 512, D, 2}; pg8::StaticOrder S; S.init(M, D, F.G, F.bid);
                pg8::EpiBf16 E{WSP(bf16, WS_PO), D, A->in[I_PSCALE] + e * D};
                pg8::gemm_phase<pg8::EpiBf16, pg8::StaticOrder, true, true>(F.lds, g, S, E);
                SEAM(pb + 3);
            }
        }
        if (IN(pb + 4)) { CArgs* A = kargs(pb + 4); Frame F = mkframe(A); unsigned char* ws = A->ws; float* X = WSP(float, WS_X);
            const bool ev = (l & 1) == 0;
            pg8::Gemm g{ev ? WSP(const bf16, WS_AB) : WSP(const bf16, WS_PO), ev ? WSP(const bf16, WS_WOUTE) + (size_t)e * D * 4096 : WSP(const bf16, WS_WOUTO) + (size_t)e * D * D, M, D, ev ? 4096 : D, ev ? 4096 : D, 0};
            pg8::StaticOrder S; S.init(M, D, F.G, F.bid);
            pg8::EpiRes E{l == 0 ? A->in[I_XP] : X, l == 0 ? A->in[I_XS] : X + (size_t)MC * D, X, WSP(const float, WS_MOD) + (size_t)l * 5 * NMOD + 2 * D};
            pg8::gemm_phase<pg8::EpiRes, pg8::StaticOrder, true, true>(F.lds, g, S, E);
            SEAM(pb + 4);
        }
        if (IN(pb + 5)) { CArgs* A = kargs(pb + 5); Frame F = mkframe(A); unsigned char* ws = A->ws; float* X = WSP(float, WS_X);
            norm_phase(F, X, X + (size_t)MC * D, A->in[I_NFFN] + l * D, WSP(const float, WS_MOD) + (size_t)l * 5 * NMOD, 3, WSP(bf16, WS_H)); SEAM(pb + 5); }
        if (IN(pb + 6)) { CArgs* A = kargs(pb + 6); Frame F = mkframe(A); unsigned char* ws = A->ws;
            pg8::Gemm g{WSP(bf16, WS_H), WSP(const bf16, WS_WUP) + (size_t)l * NFU * D, M, NFU, D, D, 0}; pg8::StaticOrder S; S.init(M, NFU, F.G, F.bid);
            pg8::EpiFfnUp E{WSP(bf16, WS_G)};
            pg8::gemm_phase<pg8::EpiFfnUp, pg8::StaticOrder, true, true>(F.lds, g, S, E);
            SEAM(pb + 6);
        }
        if (IN(pb + 7)) { CArgs* A = kargs(pb + 7); Frame F = mkframe(A); unsigned char* ws = A->ws; float* X = WSP(float, WS_X);
            pg8::Gemm g{WSP(bf16, WS_G), WSP(const bf16, WS_WDN) + (size_t)l * D * FF, M, D, FF, FF, 0}; pg8::StaticOrder S; S.init(M, D, F.G, F.bid);
            pg8::EpiRes E{X, X + (size_t)MC * D, X, WSP(const float, WS_MOD) + (size_t)l * 5 * NMOD + 5 * D};
            pg8::gemm_phase<pg8::EpiRes, pg8::StaticOrder, true, true>(F.lds, g, S, E);
            SEAM(pb + 7);
        }
    }
    if (IN(33)) { CArgs* A = kargs(33); Frame F = mkframe(A); unsigned char* ws = A->ws; final_norm_phase(F, WSP(const float, WS_X), A->in[I_FNORM], A->out); }
#undef IN
#undef SEAM
}

extern "C" void kernel_launch(void* const* d_in, const int* in_sizes, int n_in, void* d_out, int out_size, void* d_ws, size_t ws_size, hipStream_t stream) {
    static int grid = 0;
    if (grid == 0) {
        if (n_in != 28 || ws_size < WS_END) { fprintf(stderr, "kernel_launch: unexpected n_in %d / ws_size %zu (need %zu)\n", n_in, ws_size, (size_t)WS_END); grid = -1; return; }
        int dev = 0, cus = 0, per_cu = 0;
        if (hipGetDevice(&dev) != hipSuccess || hipDeviceGetAttribute(&cus, hipDeviceAttributeMultiprocessorCount, dev) != hipSuccess) { grid = -1; return; }
        if (hipFuncSetAttribute((const void*)mega_fwd, hipFuncAttributeMaxDynamicSharedMemorySize, LDS_BYTES) != hipSuccess) { fprintf(stderr, "kernel_launch: hipFuncSetAttribute failed\n"); grid = -1; return; }
        if (hipOccupancyMaxActiveBlocksPerMultiprocessor(&per_cu, (const void*)mega_fwd, NTHR, LDS_BYTES) != hipSuccess || per_cu < 1) fprintf(stderr, "kernel_launch: occupancy query says %d\n", per_cu);
        (void)hipGetLastError();
        grid = cus;
    }
    if (grid < 0) return;
    if (hipMemsetAsync((char*)d_ws + WS_CTL, 0, CTL_ZERO_BYTES, stream) != hipSuccess) return;
    Args a{};
    for (int i = 0; i < 28; ++i) a.in[i] = (const float*)d_in[i];
    a.out = (float*)d_out; a.ws = (unsigned char*)d_ws; a.pad = 0;
#if MK_PER_PHASE
    for (int ph = 0; ph < NPHASES; ++ph) { a.ph_lo = ph; a.ph_hi = ph + 1; a.li = 0;
        hipLaunchKernelGGL(mega_fwd, dim3(grid), dim3(NTHR), LDS_BYTES, stream, a); }
#else
    a.ph_lo = 0; a.ph_hi = NPHASES; a.li = 0;
    hipLaunchKernelGGL(mega_fwd, dim3(grid), dim3(NTHR), LDS_BYTES, stream, a);
#endif
}
```

```cpp
#include <hip/hip_runtime.h>
#include <cstdio>
#include <cstdint>

#ifndef PROBE_REP_MASK
#define PROBE_REP_MASK 0
#endif
#ifndef MK_PER_PHASE
#define MK_PER_PHASE 0
#endif

constexpr int D = 2048, MC = 8192, MS = 16384, M = MC + MS, DEPTH = 4, FF = 5632, NFU = 2 * FF;
constexpr int IN_EVEN = 9280, IN_PAD = 9472, PROJ_LD = 9216, CCONV = 3072;
constexpr int NH = 32, HP = 64, NST = 128;
constexpr int SEQ_C = 256, NB_C = 32, SEQ_S = 4096, NB_S = 4;
constexpr int NMOD = 6 * D;
constexpr float EPS = 1e-6f;
constexpr int NWAVES = 8, NTHR = 512;

constexpr size_t MiB = 1u << 20;
constexpr size_t WS_CTL = 0, CTL_ZERO_BYTES = 2 * MiB;
constexpr size_t WS_MOD = 1 * MiB;
constexpr size_t WS_WINE = 4 * MiB;
constexpr size_t WS_WOUTE = 78 * MiB;
constexpr size_t WS_WINO = 110 * MiB;
constexpr size_t WS_WOUTO = 126 * MiB;
constexpr size_t WS_WPOOL = 142 * MiB;
constexpr size_t WS_W2T = 1304 * MiB;
constexpr size_t WS_WUP = 146 * MiB;
constexpr size_t WS_WDN = 322 * MiB;
constexpr size_t WS_X = 410 * MiB;
constexpr size_t WS_H = 602 * MiB;
constexpr size_t WS_PROJ = 698 * MiB;
constexpr size_t WS_G = WS_PROJ;
constexpr size_t WS_HC = WS_PROJ;
constexpr size_t WS_PL = WS_PROJ + 96 * MiB;
constexpr size_t WS_PO = WS_PROJ + 192 * MiB;
constexpr size_t WS_DT = 1130 * MiB;
constexpr size_t WS_GWSB = 2 * MiB;
constexpr size_t WS_CSN = 1136 * MiB;
constexpr size_t WS_BTG = 1160 * MiB;
constexpr size_t WS_CBP = 1184 * MiB;
constexpr size_t WS_XST = 1208 * MiB;
constexpr size_t WS_YF = 1328 * MiB;
constexpr size_t WS_YB = 1424 * MiB;
constexpr size_t WS_DELTA = WS_YF;
constexpr size_t WS_ACS = 1520 * MiB;
constexpr size_t WS_DTV = 1526 * MiB;
constexpr size_t WS_END = 1532 * MiB;
static_assert(WS_WINE + (size_t)2 * IN_PAD * D * 2 <= WS_WOUTE, "map");
static_assert(WS_WUP + (size_t)4 * NFU * D * 2 <= WS_WDN && WS_WDN + (size_t)4 * D * FF * 2 <= WS_X, "map");
static_assert(WS_X + (size_t)M * D * 4 <= WS_H && WS_H + (size_t)M * D * 2 <= WS_PROJ, "map");
static_assert(WS_PROJ + (size_t)M * PROJ_LD * 2 <= WS_DT && WS_DT + (size_t)M * 64 * 4 <= WS_CSN, "map");
static_assert(WS_CSN + (size_t)M * 512 * 2 <= WS_BTG && WS_BTG + (size_t)M * 512 * 2 <= WS_CBP && WS_CBP + (size_t)M * 512 * 2 <= WS_XST && WS_XST + (size_t)M * D * 2 <= WS_YF, "map");
static_assert(WS_YB + (size_t)M * D * 2 <= WS_ACS && WS_DTV + (size_t)M * 64 * 4 <= WS_END, "map");
constexpr int CW_TMO = 0;
constexpr int CW_BAR = 4096;

constexpr int RING_BYTES = 131072;
constexpr int LDS_BYTES = 155648;
constexpr int MISC_OFF = LDS_BYTES - 256;

#define GAS __attribute__((address_space(1)))
#define LAS __attribute__((address_space(3)))
typedef unsigned short bf16;
typedef unsigned v4u __attribute__((ext_vector_type(4)));
typedef unsigned v2u __attribute__((ext_vector_type(2)));
typedef float f32x4 __attribute__((ext_vector_type(4)));
typedef float f32x2 __attribute__((ext_vector_type(2)));
typedef short bf16x8 __attribute__((ext_vector_type(8)));
#define LDS_WAIT() asm volatile("s_waitcnt lgkmcnt(0)" ::: "memory")
#define VM_WAIT() asm volatile("s_waitcnt vmcnt(0)" ::: "memory")

__device__ __forceinline__ unsigned f2bf(float f) { unsigned u = __builtin_bit_cast(unsigned, f); return (u + 0x7fffu + ((u >> 16) & 1u)) >> 16; }
typedef __bf16 hwbf16x2 __attribute__((ext_vector_type(2)));
__device__ __forceinline__ unsigned pk2(float lo, float hi) { const f32x2 v = {lo, hi}; return __builtin_bit_cast(unsigned, __builtin_convertvector(v, hwbf16x2)); }
__device__ __forceinline__ float bf2f(unsigned b) { return __builtin_bit_cast(float, b << 16); }
__device__ __forceinline__ float bflo(unsigned w) { return __builtin_bit_cast(float, w << 16); }
__device__ __forceinline__ float bfhi(unsigned w) { return __builtin_bit_cast(float, w & 0xffff0000u); }
__device__ __forceinline__ float silu_f(float x) { return x * __builtin_amdgcn_rcpf(1.0f + __expf(-x)); }
__device__ __forceinline__ float gelu_tanh_f(float x) {
    const float y2 = -1.5957691216057308f * x * (1.0f + 0.044715f * x * x);
    return x * __builtin_amdgcn_rcpf(1.0f + __expf(y2));
}
__device__ __forceinline__ float softplus_f(float x) { return x > 20.f ? x : log1pf(__expf(x)); }
__device__ __forceinline__ float wave_sum(float v) {
#pragma unroll
    for (int o = 1; o < 64; o <<= 1) v += __shfl_xor(v, o);
    return v;
}
__device__ __forceinline__ int cond_idx(int row) { return row < MC ? 4 : ((row - MC) >> 12); }

namespace pg8 {
#define PG8_LAS __attribute__((address_space(3)))
typedef unsigned short bf16_t;
constexpr int BM = 256, BK = 64, HALF = 128, HTB = HALF * BK * 2, STAGE_BYTES = 8 * HTB, NXCD = 8, WGM = 8;
__host__ __device__ __forceinline__ int lds_byte(int r, int c) { const int st = (r >> 4) * 2 + (c >> 5), rr = r & 15, cc = c & 31, ob = rr * 64 + cc * 2; return st * 1024 + (ob ^ (((ob >> 9) & 1) << 5)); }
__host__ __device__ __forceinline__ void stage_rc(int b, int& R, int& C) { const int st = b / 1024, sb = b % 1024, swz = sb ^ (((sb >> 9) & 1) << 5); R = (st >> 1) * 16 + swz / 64; C = (st & 1) * 32 + (swz % 64) / 2; }
__host__ __device__ __forceinline__ int perm32(int rho) { const int n = rho >> 4, i = rho & 15; return 8 * (i >> 2) + 4 * n + (i & 3); }

struct Unit { int pm, pn; };
struct Gemm { const bf16_t* A; const bf16_t* Bt; int M, N, K, lda, agrp, bgrp; };

struct StaticOrder {
    int nM, nN, nwg, G, c, wgm;
    __host__ __device__ void init(int M_, int N_, int G_, int c_, int wgm_ = WGM) { nM = M_ / BM; nN = N_ / BM; nwg = nM * nN; G = G_; c = c_; wgm = wgm_; }
    __host__ __device__ bool next(int i, Unit& u) const {
        const long L = (long)i * G + c; if (L >= nwg) return false;
        int wgid = (int)L; { const int q = nwg / NXCD, r = nwg % NXCD, xcd = wgid % NXCD, off = wgid / NXCD; wgid = (xcd < r ? xcd * (q + 1) : r * (q + 1) + (xcd - r) * q) + off; }
        const int nig = wgm * nN, gid = wgid / nig, fm = gid * wgm, gsz = (nM - fm) < wgm ? (nM - fm) : wgm;
        u.pm = fm + ((wgid % nig) % gsz); u.pn = (wgid % nig) / gsz; return true;
    }
    __device__ __forceinline__ void a_ready(const Unit&) const {}
    __device__ __forceinline__ void done(const Unit&) const {}
};

__device__ __forceinline__ unsigned cvt_pk_bf16(float lo, float hi) { unsigned r; asm volatile("v_cvt_pk_bf16_f32 %0, %1, %2" : "=v"(r) : "v"(lo), "v"(hi)); return r; }


struct EpiInEven {
    static constexpr bool PERM = true, AFTER_DRAIN = false;
    bf16_t* P; float* DT;
    __device__ __forceinline__ void operator()(const f32x4 (&acc)[2][2][4][2], const Unit& u, int wr, int wc, int fr, int fq) const {
        const int row0 = u.pm * BM + wr * 64 + fr;
        if (u.pn < 36) {
            const int mode = u.pn < 16 ? 0 : (u.pn < 24 ? 1 : 2);
            const int col0 = u.pn * BM + wc * 32 + 8 * fq;
#pragma unroll
            for (int ai = 0; ai < 2; ++ai)
#pragma unroll
                for (int m = 0; m < 4; ++m) { bf16_t* rowp = P + (size_t)(row0 + ai * HALF + m * 16) * PROJ_LD + col0;
#pragma unroll
                    for (int bj = 0; bj < 2; ++bj) { f32x4 v0 = acc[ai][bj][m][0], v1 = acc[ai][bj][m][1];
                        if (mode == 0) {
#pragma unroll
                            for (int j = 0; j < 4; ++j) { v0[j] = gelu_tanh_f(v0[j]); v1[j] = gelu_tanh_f(v1[j]); } }
                        else if (mode == 1) {
#pragma unroll
                            for (int j = 0; j < 4; ++j) { v0[j] = silu_f(v0[j]); v1[j] = silu_f(v1[j]); } }
                        v4u w; w.x = cvt_pk_bf16(v0[0], v0[1]); w.y = cvt_pk_bf16(v0[2], v0[3]); w.z = cvt_pk_bf16(v1[0], v1[1]); w.w = cvt_pk_bf16(v1[2], v1[3]);
                        *(v4u*)(rowp + bj * HALF) = w; } }
        } else if (wc < 2) {
#pragma unroll
            for (int ai = 0; ai < 2; ++ai)
#pragma unroll
                for (int m = 0; m < 4; ++m) { float* rp = DT + (size_t)(row0 + ai * HALF + m * 16) * 64 + wc * 32 + 8 * fq;
                    *(f32x4*)rp = acc[ai][0][m][0]; *(f32x4*)(rp + 4) = acc[ai][0][m][1]; }
        }
    }
};
struct EpiBf16 {
    static constexpr bool PERM = true, AFTER_DRAIN = false;
    bf16_t* O; int ldc; const float* scale;
    __device__ __forceinline__ void operator()(const f32x4 (&acc)[2][2][4][2], const Unit& u, int wr, int wc, int fr, int fq) const {
        const int row0 = u.pm * BM + wr * 64 + fr, col0 = u.pn * BM + wc * 32 + 8 * fq;
        f32x4 sv[2][2];
#pragma unroll
        for (int bj = 0; bj < 2; ++bj)
#pragma unroll
            for (int n = 0; n < 2; ++n) sv[bj][n] = scale ? *(const f32x4*)(scale + col0 + bj * HALF + 4 * n) : (f32x4){1.f, 1.f, 1.f, 1.f};
#pragma unroll
        for (int ai = 0; ai < 2; ++ai)
#pragma unroll
            for (int m = 0; m < 4; ++m) { bf16_t* rowp = O + (size_t)(row0 + ai * HALF + m * 16) * ldc + col0;
#pragma unroll
                for (int bj = 0; bj < 2; ++bj) { const f32x4 v0 = acc[ai][bj][m][0] * sv[bj][0], v1 = acc[ai][bj][m][1] * sv[bj][1];
                    v4u w; w.x = cvt_pk_bf16(v0[0], v0[1]); w.y = cvt_pk_bf16(v0[2], v0[3]); w.z = cvt_pk_bf16(v1[0], v1[1]); w.w = cvt_pk_bf16(v1[2], v1[3]);
                    *(v4u*)(rowp + bj * HALF) = w; } }
    }
};
struct EpiRes {
    static constexpr bool PERM = false, AFTER_DRAIN = false;
    const float* base_c; const float* base_s; float* X; const float* gate;
    __device__ __forceinline__ void operator()(const f32x4 (&acc)[2][2][4][2], const Unit& u, int wr, int wc, int fr, int fq) const {
        const int rowt = u.pm * BM, row0 = rowt + wr * 64 + fr, col0 = u.pn * BM + wc * 32 + 4 * fq;
        const float* g = gate + (size_t)cond_idx(rowt) * NMOD + col0;
        const float* bp = rowt < MC ? base_c + (size_t)row0 * D : base_s + (size_t)(row0 - MC) * D;
        f32x4 gv[2][2];
#pragma unroll
        for (int bj = 0; bj < 2; ++bj)
#pragma unroll
            for (int n = 0; n < 2; ++n) gv[bj][n] = *(const f32x4*)(g + bj * HALF + n * 16);
#pragma unroll
        for (int ai = 0; ai < 2; ++ai) {
            f32x4 bb[4][2][2];
#pragma unroll
            for (int m = 0; m < 4; ++m)
#pragma unroll
                for (int bj = 0; bj < 2; ++bj)
#pragma unroll
                    for (int n = 0; n < 2; ++n) bb[m][bj][n] = *(const f32x4*)(bp + (size_t)(ai * HALF + m * 16) * D + col0 + bj * HALF + n * 16);
#pragma unroll
            for (int m = 0; m < 4; ++m) { float* xo = X + (size_t)(row0 + ai * HALF + m * 16) * D + col0;
#pragma unroll
                for (int bj = 0; bj < 2; ++bj)
#pragma unroll
                    for (int n = 0; n < 2; ++n) *(f32x4*)(xo + bj * HALF + n * 16) = bb[m][bj][n] + gv[bj][n] * acc[ai][bj][m][n]; }
            asm volatile("" ::: "memory"); }
    }
};
struct EpiDelta {
    static constexpr bool PERM = true, AFTER_DRAIN = false;
    bf16_t* O; const float* gate;
    __device__ __forceinline__ void operator()(const f32x4 (&acc)[2][2][4][2], const Unit& u, int wr, int wc, int fr, int fq) const {
        const int rowt = u.pm * BM, row0 = rowt + wr * 64 + fr, col0 = u.pn * BM + wc * 32 + 8 * fq;
        const float* g = gate + (size_t)cond_idx(rowt) * NMOD + col0;
        f32x4 sv[2][2];
#pragma unroll
        for (int bj = 0; bj < 2; ++bj)
#pragma unroll
            for (int n = 0; n < 2; ++n) sv[bj][n] = *(const f32x4*)(g + bj * HALF + 4 * n);
#pragma unroll
        for (int ai = 0; ai < 2; ++ai)
#pragma unroll
            for (int m = 0; m < 4; ++m) { bf16_t* rowp = O + (size_t)(row0 + ai * HALF + m * 16) * D + col0;
#pragma unroll
                for (int bj = 0; bj < 2; ++bj) { const f32x4 v0 = acc[ai][bj][m][0] * sv[bj][0], v1 = acc[ai][bj][m][1] * sv[bj][1];
                    v4u w; w.x = cvt_pk_bf16(v0[0], v0[1]); w.y = cvt_pk_bf16(v0[2], v0[3]); w.z = cvt_pk_bf16(v1[0], v1[1]); w.w = cvt_pk_bf16(v1[2], v1[3]);
                    *(v4u*)(rowp + bj * HALF) = w; } }
    }
};
struct EpiFfnUp {
    static constexpr bool PERM = true, AFTER_DRAIN = false;
    bf16_t* G;
    __device__ __forceinline__ void operator()(const f32x4 (&acc)[2][2][4][2], const Unit& u, int wr, int wc, int fr, int fq) const {
        const int row0 = u.pm * BM + wr * 64 + fr, col0 = u.pn * HALF + wc * 32 + 8 * fq;
#pragma unroll
        for (int ai = 0; ai < 2; ++ai)
#pragma unroll
            for (int m = 0; m < 4; ++m) { bf16_t* rowp = G + (size_t)(row0 + ai * HALF + m * 16) * FF + col0;
                f32x4 v0, v1;
#pragma unroll
                for (int j = 0; j < 4; ++j) { v0[j] = silu_f(acc[ai][0][m][0][j]) * acc[ai][1][m][0][j]; v1[j] = silu_f(acc[ai][0][m][1][j]) * acc[ai][1][m][1][j]; }
                v4u w; w.x = cvt_pk_bf16(v0[0], v0[1]); w.y = cvt_pk_bf16(v0[2], v0[3]); w.z = cvt_pk_bf16(v1[0], v1[1]); w.w = cvt_pk_bf16(v1[2], v1[3]);
                *(v4u*)rowp = w; }
    }
};

template <class Epi, class Sched, bool ALIGN_EPI = false, bool SP2 = false>
__device__ __forceinline__ void gemm_phase(PG8_LAS unsigned char* lds, const Gemm g, const Sched& S, const Epi& E) {
    int tid = threadIdx.x; asm volatile("" : "+v"(tid));
    const int wid = __builtin_amdgcn_readfirstlane(tid >> 6), lane = tid & 63, wr = wid >> 2, wc = wid & 3, fr = lane & 15, fq = lane >> 4;
    const int K = g.K, nt = K / BK, lda = g.lda;
    unsigned voffA[2], voffB[2];
#pragma unroll
    for (int i = 0; i < 2; ++i) { int R, C; stage_rc(tid * 16 + i * 8192, R, C); const int Rb = Epi::PERM ? ((R & ~31) + perm32(R & 31)) : R;
        voffA[i] = (unsigned)(R * lda + C) * 2u; voffB[i] = (unsigned)(Rb * K + C) * 2u; }
    const size_t kstep = (size_t)(BK * 2);
    const size_t hstepA = (size_t)HALF * lda * 2, hstepB = (size_t)HALF * K * 2;
    const size_t tstepA = 2 * hstepA, tstepB = 2 * hstepB;
    const unsigned ldsw = (unsigned)wid * 1024u;
    const int aoff = lds_byte(wr * 64 + fr, fq * 8), boff = lds_byte(wc * 32 + fr, fq * 8);
#define PG8_SA(b, h) (((b) * 2 + (h)) * HTB)
#define PG8_SB(b, h) ((4 + (b) * 2 + (h)) * HTB)
#define PG8_STAGE(bufoff, gbase, voff) do { _Pragma("unroll") for (int _i = 0; _i < 2; ++_i) \
        __builtin_amdgcn_global_load_lds((const unsigned*)((const char*)(gbase) + (voff)[_i]), (PG8_LAS unsigned*)(lds + (bufoff) + ldsw + _i * 8192), 16, 0, 0); } while (0)
#define PG8_LDA(dst, b, h) do { _Pragma("unroll") for (int m = 0; m < 4; ++m) _Pragma("unroll") for (int k = 0; k < 2; ++k) dst[m][k] = *(const PG8_LAS bf16x8*)(lds + PG8_SA(b, h) + aoff + m * 2048 + k * 1024); } while (0)
#define PG8_LDB(dst, b, h) do { _Pragma("unroll") for (int n = 0; n < 2; ++n) _Pragma("unroll") for (int k = 0; k < 2; ++k) dst[n][k] = *(const PG8_LAS bf16x8*)(lds + PG8_SB(b, h) + boff + n * 2048 + k * 1024); } while (0)
#define PG8_MMA(ai, bj, At, Bt) do { __builtin_amdgcn_s_setprio(1); _Pragma("unroll") for (int m = 0; m < 4; ++m) _Pragma("unroll") for (int n = 0; n < 2; ++n) _Pragma("unroll") for (int k = 0; k < 2; ++k) \
        acc[ai][bj][m][n] = __builtin_amdgcn_mfma_f32_16x16x32_bf16(Bt[n][k], At[m][k], acc[ai][bj][m][n], 0, 0, 0); __builtin_amdgcn_s_setprio(0); } while (0)
#define PG8_WAIT_V(n) asm volatile("s_waitcnt vmcnt(" #n ")" ::: "memory")
#define PG8_WAIT_L(n) asm volatile("s_waitcnt lgkmcnt(" #n ")" ::: "memory")
#define PG8_BAR __builtin_amdgcn_s_barrier()
#define PG8_SCHED __builtin_amdgcn_sched_barrier(0)
#define PG8_ABASE(u) ((const char*)g.A + (size_t)(u).pm * tstepA + (g.agrp ? (size_t)((u).pn / g.agrp) * (size_t)K * 2 : (size_t)0))
#define PG8_BBASE(u) ((const char*)g.Bt + (size_t)((g.bgrp ? ((u).pm / g.bgrp) * (g.N / BM) : 0) + (u).pn) * tstepB)
    Unit cur, nxt; int ui = 0;
    if (!S.next(0, cur)) return;
    f32x4 acc[2][2][4][2];
#pragma unroll
    for (int a = 0; a < 2; ++a)
#pragma unroll
        for (int b = 0; b < 2; ++b)
#pragma unroll
            for (int m = 0; m < 4; ++m)
#pragma unroll
                for (int n = 0; n < 2; ++n) acc[a][b][m][n] = (f32x4){0.f, 0.f, 0.f, 0.f};
    bf16x8 At[4][2], B0[2][2], B1[2][2];
    const char* cA = PG8_ABASE(cur); const char* cB = PG8_BBASE(cur);
    S.a_ready(cur);
    if constexpr (SP2) {
        PG8_STAGE(PG8_SB(0, 0), cB, voffB); PG8_STAGE(PG8_SB(0, 1), cB + hstepB, voffB); PG8_STAGE(PG8_SA(0, 0), cA, voffA); PG8_STAGE(PG8_SA(0, 1), cA + hstepA, voffA);
        if (wr == 1) PG8_BAR;
        PG8_WAIT_V(2); PG8_BAR;
        PG8_STAGE(PG8_SB(1, 0), cB + kstep, voffB); PG8_STAGE(PG8_SA(1, 0), cA + kstep, voffA); PG8_STAGE(PG8_SB(1, 1), cB + hstepB + kstep, voffB);
        PG8_WAIT_V(6); PG8_BAR;
    } else {
        PG8_STAGE(PG8_SB(0, 0), cB, voffB); PG8_STAGE(PG8_SA(0, 0), cA, voffA); PG8_STAGE(PG8_SB(0, 1), cB + hstepB, voffB); PG8_STAGE(PG8_SA(0, 1), cA + hstepA, voffA);
        if (wr == 1) PG8_BAR;
        PG8_WAIT_V(4); PG8_BAR;
        PG8_STAGE(PG8_SB(1, 0), cB + kstep, voffB); PG8_STAGE(PG8_SA(1, 0), cA + kstep, voffA); PG8_STAGE(PG8_SB(1, 1), cB + hstepB + kstep, voffB);
        PG8_WAIT_V(6); PG8_BAR;
    }
    for (;;) {
        const bool has_next = S.next(ui + 1, nxt);
        const char* nA = has_next ? PG8_ABASE(nxt) : cA; const char* nB = has_next ? PG8_BBASE(nxt) : cB;
        for (int t = 0; t < nt; t += 2) {
            const bool last = (t == nt - 2);
            const char* a1 = cA + (size_t)(t + 1) * kstep;
            const char* a2 = last ? nA : cA + (size_t)(t + 2) * kstep; const char* b2 = last ? nB : cB + (size_t)(t + 2) * kstep;
            const char* a3 = a2 + kstep; const char* b3 = b2 + kstep;
            if (last && has_next) S.a_ready(nxt);
            if constexpr (SP2) {
            PG8_LDB(B0, 0, 0); PG8_LDB(B1, 0, 1); PG8_SCHED; PG8_LDA(At, 0, 0); PG8_STAGE(PG8_SA(1, 1), a1 + hstepA, voffA);
            PG8_WAIT_V(8); PG8_WAIT_L(0); PG8_BAR; PG8_MMA(0, 0, At, B0); PG8_MMA(0, 1, At, B1); PG8_BAR; PG8_SCHED;
            PG8_LDA(At, 0, 1); PG8_STAGE(PG8_SB(0, 0), b2, voffB); PG8_STAGE(PG8_SB(0, 1), b2 + hstepB, voffB); PG8_STAGE(PG8_SA(0, 0), a2, voffA);
            PG8_WAIT_V(8); PG8_WAIT_L(0); PG8_BAR; PG8_MMA(1, 0, At, B0); PG8_MMA(1, 1, At, B1); PG8_BAR; PG8_SCHED;
            PG8_LDB(B0, 1, 0); PG8_LDB(B1, 1, 1); PG8_SCHED; PG8_LDA(At, 1, 0); PG8_STAGE(PG8_SA(0, 1), a2 + hstepA, voffA);
            PG8_WAIT_V(8); PG8_WAIT_L(0); PG8_BAR; PG8_MMA(0, 0, At, B0); PG8_MMA(0, 1, At, B1); PG8_BAR; PG8_SCHED;
            PG8_LDA(At, 1, 1); PG8_STAGE(PG8_SB(1, 0), b3, voffB); PG8_STAGE(PG8_SB(1, 1), b3 + hstepB, voffB); PG8_STAGE(PG8_SA(1, 0), a3, voffA);
            PG8_WAIT_V(8); PG8_WAIT_L(0); PG8_BAR; PG8_MMA(1, 0, At, B0); PG8_MMA(1, 1, At, B1); PG8_BAR; PG8_SCHED;
            } else {
            PG8_LDB(B0, 0, 0); PG8_SCHED; PG8_LDA(At, 0, 0); PG8_STAGE(PG8_SA(1, 1), a1 + hstepA, voffA);
            PG8_WAIT_L(8); PG8_BAR; PG8_WAIT_L(0); PG8_MMA(0, 0, At, B0); PG8_BAR; PG8_SCHED;
            PG8_LDB(B1, 0, 1); PG8_STAGE(PG8_SB(0, 0), b2, voffB);
            PG8_BAR; PG8_WAIT_L(0); PG8_MMA(0, 1, At, B1); PG8_BAR;
            PG8_LDA(At, 0, 1); PG8_STAGE(PG8_SA(0, 0), a2, voffA);
            PG8_BAR; PG8_WAIT_L(0); PG8_MMA(1, 0, At, B0); PG8_BAR; PG8_SCHED;
            PG8_STAGE(PG8_SB(0, 1), b2 + hstepB, voffB);
            PG8_WAIT_V(6); PG8_BAR; PG8_MMA(1, 1, At, B1); PG8_BAR;
            PG8_LDB(B0, 1, 0); PG8_SCHED; PG8_LDA(At, 1, 0); PG8_STAGE(PG8_SA(0, 1), a2 + hstepA, voffA);
            PG8_WAIT_L(8); PG8_BAR; PG8_WAIT_L(0); PG8_MMA(0, 0, At, B0); PG8_BAR; PG8_SCHED;
            PG8_LDB(B1, 1, 1); PG8_STAGE(PG8_SB(1, 0), b3, voffB);
            PG8_BAR; PG8_WAIT_L(0); PG8_MMA(0, 1, At, B1); PG8_BAR;
            PG8_LDA(At, 1, 1); PG8_STAGE(PG8_SA(1, 0), a3, voffA);
            PG8_BAR; PG8_WAIT_L(0); PG8_MMA(1, 0, At, B0); PG8_BAR; PG8_SCHED;
            PG8_STAGE(PG8_SB(1, 1), b3 + hstepB, voffB);
            PG8_WAIT_V(6); PG8_BAR; PG8_MMA(1, 1, At, B1); PG8_BAR;
            }
        }
        if constexpr (ALIGN_EPI) { if (wr == 0) PG8_BAR; }
        if constexpr (!Epi::AFTER_DRAIN) { E(acc, cur, wr, wc, fr, fq); S.done(cur); }
        if (!has_next) break;
#pragma unroll
        for (int a = 0; a < 2; ++a)
#pragma unroll
            for (int b = 0; b < 2; ++b)
#pragma unroll
                for (int m = 0; m < 4; ++m)
#pragma unroll
                    for (int n = 0; n < 2; ++n) acc[a][b][m][n] = (f32x4){0.f, 0.f, 0.f, 0.f};
        cur = nxt; cA = nA; cB = nB; ++ui;
        if constexpr (ALIGN_EPI) { if (wr == 1) PG8_BAR; }
    }
    PG8_WAIT_V(0);
    if constexpr (!ALIGN_EPI) { if (wr == 0) PG8_BAR; }
    PG8_BAR;
#undef PG8_SA
#undef PG8_SB
#undef PG8_STAGE
#undef PG8_LDA
#undef PG8_LDB
#undef PG8_MMA
#undef PG8_WAIT_V
#undef PG8_WAIT_L
#undef PG8_BAR
#undef PG8_SCHED
#undef PG8_ABASE
#undef PG8_BBASE
}
}

#define XB_TMO      128
#define XB_XCNT(j)  (256  + 64 * (j))
#define XB_XSUB(j)  (1280 + 64 * (j))
#define XB_XGEN(j)  (2304 + 64 * (j))
#define XB_TOP      3328
#define XB_TOPGEN   3392
#define XCD_BAR_WORDS 3456
#define XB_SPIN_CAP (1u << 18)
__device__ __forceinline__ unsigned xb_ld(unsigned* p)              { return __hip_atomic_load(p, __ATOMIC_RELAXED, __HIP_MEMORY_SCOPE_AGENT); }
__device__ __forceinline__ unsigned xb_add(unsigned* p, unsigned v) { return __hip_atomic_fetch_add(p, v, __ATOMIC_RELAXED, __HIP_MEMORY_SCOPE_AGENT); }
__device__ __forceinline__ unsigned xb_xcc_id() { return (unsigned)__builtin_amdgcn_s_getreg((3 << 11) | 20) & 0xFu; }
#define XB_SPIN(cond, bar) do { unsigned _sp = 0; while (cond) { __builtin_amdgcn_s_sleep(1); \
    if ((++_sp & 255u) == 0u) { if (xb_ld(&(bar)[XB_TMO])) break; if (_sp > XB_SPIN_CAP) { atomicAdd(&(bar)[XB_TMO], 1u); break; } } } } while (0)
struct XcdBarrier { unsigned* bar; unsigned x; volatile LAS unsigned* st; };
__device__ __forceinline__ XcdBarrier xcd_barrier_post(unsigned* bar, volatile LAS unsigned* st) {
    XcdBarrier b; b.bar = bar; b.x = xb_xcc_id(); b.st = st;
    if (threadIdx.x == 0) (void)xb_add(&bar[XB_XCNT(b.x)], 1u);
    return b;
}
__device__ __forceinline__ void xcd_barrier_complete(unsigned* bar, unsigned x, unsigned& nloc, unsigned& nx) {
    const unsigned G = gridDim.x * gridDim.y * gridDim.z;
    unsigned sum, cnt, mine, sp = 0u;
    for (;;) {
        sum = 0u; cnt = 0u; mine = 0u;
#pragma unroll
        for (unsigned j = 0; j < 16; ++j) { const unsigned c = xb_ld(&bar[XB_XCNT(j)]); sum += c; cnt += (c > 0u) ? 1u : 0u; mine = (j == x) ? c : mine; }
        if (sum == G) break;
        __builtin_amdgcn_s_sleep(1);
        if ((++sp & 255u) == 0u) { if (xb_ld(&bar[XB_TMO])) break; if (sp > XB_SPIN_CAP) { atomicAdd(&bar[XB_TMO], 1u); break; } }
    }
    nloc = mine > 0u ? mine : 1u; nx = cnt > 0u ? cnt : 1u;
}
__device__ __forceinline__ void xcd_barrier(const XcdBarrier& b) {
    asm volatile("s_waitcnt vmcnt(0)" ::: "memory");
    __syncthreads();
    if (threadIdx.x == 0) {
        unsigned* bar = b.bar;
        __builtin_amdgcn_s_waitcnt(0);
        unsigned nloc = b.st[0], nx = b.st[1];
        if (nloc == 0u) { xcd_barrier_complete(bar, b.x, nloc, nx); b.st[0] = nloc; b.st[1] = nx; }
        const unsigned old = xb_add(&bar[XB_XSUB(b.x)], 1u);
        const unsigned gen = old / nloc;
        if (old + 1u == (gen + 1u) * nloc) {
            __builtin_amdgcn_fence(__ATOMIC_RELEASE, "agent");
            asm volatile("s_waitcnt vmcnt(0)" ::: "memory");
            const unsigned og = xb_add(&bar[XB_TOP], 1u);
            const unsigned tg = og / nx;
            if (og + 1u == (tg + 1u) * nx) xb_add(&bar[XB_TOPGEN], 1u);
            else XB_SPIN(xb_ld(&bar[XB_TOPGEN]) == tg, bar);
            __builtin_amdgcn_fence(__ATOMIC_ACQUIRE, "agent");
            xb_add(&bar[XB_XGEN(b.x)], 1u);
            asm volatile("s_waitcnt vmcnt(0)" ::: "memory");
        } else {
            XB_SPIN(xb_ld(&bar[XB_XGEN(b.x)]) == gen, bar);
            __builtin_amdgcn_fence(__ATOMIC_ACQUIRE, "agent");
            asm volatile("s_waitcnt vmcnt(0)" ::: "memory");
        }
    }
    __syncthreads();
}

struct Args {
    const float* in[28]; float* out; unsigned char* ws; int ph_lo, ph_hi, li, pad;
};
enum { I_XP = 0, I_XS, I_STATE, I_C, I_CCTX, I_WMOD, I_BMOD, I_NMIX, I_NFFN, I_WINE, I_WOUTE, I_GNORM, I_GWS, I_GBS, I_CONVW, I_CONVB,
       I_DTB, I_ALOG, I_SSDD, I_SNORM, I_WINO, I_POOLW, I_PSCALE, I_WOUTO, I_W1, I_W3, I_W2, I_FNORM };

typedef __attribute__((address_space(4))) const Args CArgs;
__device__ __forceinline__ CArgs* kargs(int salt) { CArgs* p = (CArgs*)__builtin_amdgcn_kernarg_segment_ptr(); asm volatile("" : "+s"(p) : "s"(salt)); return p; }

struct TItem { const float* src; bf16* dst; int ldw, K; };
__device__ __forceinline__ void titem_load(const TItem& t, int lane, f32x4 (&v)[16]) {
    const int lr = lane >> 4, lc = 4 * (lane & 15);
#pragma unroll
    for (int i = 0; i < 16; ++i) v[i] = *(const f32x4*)(t.src + (size_t)(4 * i + lr) * t.ldw + lc);
}
__device__ __forceinline__ void titem_store(const TItem& t, int lane, const f32x4 (&v)[16], LAS float* scr) {
    constexpr int PT = 65;
    const int lr = lane >> 4, lc = 4 * (lane & 15);
#pragma unroll
    for (int i = 0; i < 16; ++i) { LAS float* sp = scr + (4 * i + lr) * PT + lc; sp[0] = v[i][0]; sp[1] = v[i][1]; sp[2] = v[i][2]; sp[3] = v[i][3]; }
    LDS_WAIT(); asm volatile("" ::: "memory");
    const int c = lane & 7;
#pragma unroll
    for (int j = 0; j < 8; ++j) { const int n = (lane >> 3) + 8 * j; const LAS float* sp = scr + (8 * c) * PT + n;
        v4u o; o.x = pk2(sp[0 * PT], sp[1 * PT]); o.y = pk2(sp[2 * PT], sp[3 * PT]); o.z = pk2(sp[4 * PT], sp[5 * PT]); o.w = pk2(sp[6 * PT], sp[7 * PT]);
        *(v4u*)(t.dst + (size_t)n * t.K + 8 * c) = o; }
    LDS_WAIT(); asm volatile("" ::: "memory");
}

struct Frame {
    LAS unsigned char* lds;
    volatile LAS unsigned* MISC;
    unsigned* ctl;
    int tid, lane, wave, G, bid;
    float* out; unsigned char* ws;
};

__device__ __forceinline__ Frame mkframe(CArgs* A) {
    extern __shared__ __attribute__((aligned(16))) unsigned char lds_base[];
    Frame F; int t = threadIdx.x; asm volatile("" : "+v"(t));
    F.lds = (LAS unsigned char*)lds_base; F.MISC = (volatile LAS unsigned*)(F.lds + MISC_OFF);
    F.tid = t; F.lane = t & 63; F.wave = __builtin_amdgcn_readfirstlane(t >> 6);
    int g = gridDim.x, b = blockIdx.x; asm volatile("" : "+s"(g), "+s"(b));
    F.G = g; F.bid = b; F.out = A->out; F.ws = A->ws; F.ctl = (unsigned*)(A->ws + WS_CTL);
    return F;
}
__device__ __forceinline__ TItem titem_up(CArgs& args, unsigned char* ws, int l, int r) {
    const int w3 = r / (32 * 88), q = r % (32 * 88), kb = q / 88, nb = q % 88, n0 = 64 * nb; TItem t;
    t.src = (w3 ? args.in[I_W3] : args.in[I_W1]) + (size_t)l * D * FF + (size_t)(64 * kb) * FF + n0; t.ldw = FF; t.K = D;
    t.dst = (bf16*)(ws + WS_WUP) + (size_t)l * NFU * D + (size_t)(256 * (n0 >> 7) + (n0 & 127) + (w3 ? 128 : 0)) * D + 64 * kb; return t;
}
__device__ __forceinline__ TItem titem_down(CArgs& args, unsigned char* ws, int l, int r) {
    const int kb = r / 32, nb = r % 32; TItem t;
    t.src = args.in[I_W2] + (size_t)l * FF * D + (size_t)(64 * kb) * D + 64 * nb; t.ldw = D; t.K = FF; t.dst = (bf16*)(ws + WS_WDN) + (size_t)l * D * FF + (size_t)(64 * nb) * FF + 64 * kb; return t;
}
constexpr int TI_UP = 2 * 32 * 88, TI_DN = 88 * 32;
__device__ __forceinline__ int titem_count(int set) {
    constexpr int I_INE = 2 * 32 * 145, I_OUTE = 2 * 64 * 32, I_INO = 2 * 32 * 32, I_OUTO = 2 * 32 * 32;
    return set == 0 ? I_INE + I_OUTE + I_INO + I_OUTO + TI_UP : (set == DEPTH ? TI_DN : TI_DN + TI_UP);
}
__device__ __forceinline__ TItem titem_decode(CArgs& args, unsigned char* ws, int set, int it) {
    constexpr int I_INE = 2 * 32 * 145, I_OUTE = 2 * 64 * 32, I_INO = 2 * 32 * 32, I_OUTO = 2 * 32 * 32;
    if (set > 0) { const int l = set - 1; return it < TI_DN ? titem_down(args, ws, l, it) : titem_up(args, ws, l + 1, it - TI_DN); }
    TItem t; int r = it;
    if (r < I_INE) { const int e = r / (32 * 145), q = r % (32 * 145), kb = q / 145, nb = q % 145;
        t.src = args.in[I_WINE] + (size_t)e * D * IN_EVEN + (size_t)(64 * kb) * IN_EVEN + 64 * nb; t.ldw = IN_EVEN; t.K = D; t.dst = (bf16*)(ws + WS_WINE) + (size_t)e * IN_PAD * D + (size_t)(64 * nb) * D + 64 * kb; return t; }
    r -= I_INE;
    if (r < I_OUTE) { const int e = r / (64 * 32), q = r % (64 * 32), kb = q / 32, nb = q % 32;
        t.src = args.in[I_WOUTE] + (size_t)e * 4096 * D + (size_t)(64 * kb) * D + 64 * nb; t.ldw = D; t.K = 4096; t.dst = (bf16*)(ws + WS_WOUTE) + (size_t)e * D * 4096 + (size_t)(64 * nb) * 4096 + 64 * kb; return t; }
    r -= I_OUTE;
    if (r < I_INO) { const int o = r / 1024, q = r % 1024, kb = q / 32, nb = q % 32;
        t.src = args.in[I_WINO] + (size_t)o * D * D + (size_t)(64 * kb) * D + 64 * nb; t.ldw = D; t.K = D; t.dst = (bf16*)(ws + WS_WINO) + (size_t)o * D * D + (size_t)(64 * nb) * D + 64 * kb; return t; }
    r -= I_INO;
    if (r < I_OUTO) { const int o = r / 1024, q = r % 1024, kb = q / 32, nb = q % 32;
        t.src = args.in[I_WOUTO] + (size_t)o * D * D + (size_t)(64 * kb) * D + 64 * nb; t.ldw = D; t.K = D; t.dst = (bf16*)(ws + WS_WOUTO) + (size_t)o * D * D + (size_t)(64 * nb) * D + 64 * kb; return t; }
    r -= I_OUTO;
    return titem_up(args, ws, 0, r);
}
__device__ __forceinline__ void convert_items(Frame& F, CArgs& args, int set, int gw, int NGW) {
    LAS float* scr = (LAS float*)(F.lds + F.wave * 16896);
    const int n = titem_count(set);
    int it = gw;
    if (it < n) {
        TItem t = titem_decode(args, F.ws, set, it); f32x4 v[16], nv[16];
        titem_load(t, F.lane, v);
        for (; it < n; it += NGW) {
            const int itn = it + NGW; TItem tn = t;
            if (itn < n) { tn = titem_decode(args, F.ws, set, itn); titem_load(tn, F.lane, nv); }
            titem_store(t, F.lane, v, scr);
            t = tn;
#pragma unroll
            for (int i = 0; i < 16; ++i) v[i] = nv[i];
        }
    }
}
__device__ __forceinline__ void p0_prologue(Frame& F, CArgs& args) {
    {
        LAS float* sc = (LAS float*)F.lds;
        LAS float* red = (LAS float*)(F.lds + 5 * D * 4);
        for (int i = F.tid; i < 5 * D; i += NTHR) { const int r = i / D, k = i % D; const float c = r < 4 ? args.in[I_C][r * D + k] : args.in[I_CCTX][k]; sc[i] = silu_f(c); }
        __syncthreads();
        float* MOD = (float*)(F.ws + WS_MOD);
        for (int u2 = F.bid; u2 < 2 * 4 * 96; u2 += F.G) {
            const int kh = u2 & 1, u = u2 >> 1, l = u / 96, j0 = (u % 96) * 128 + 2 * F.lane, kbase = kh * 1024 + F.wave * 128;
            const float* w = args.in[I_WMOD] + ((size_t)l * D + (size_t)kbase) * NMOD + j0;
            float a[5][2];
#pragma unroll
            for (int r = 0; r < 5; ++r) { a[r][0] = 0.f; a[r][1] = 0.f; }
#pragma unroll 16
            for (int k = 0; k < 128; ++k) { const f32x2 wv = *(const f32x2*)(w + (size_t)k * NMOD);
#pragma unroll
                for (int r = 0; r < 5; ++r) { const float sv = sc[r * D + kbase + k]; a[r][0] += sv * wv.x; a[r][1] += sv * wv.y; } }
#pragma unroll
            for (int r = 0; r < 5; ++r) { red[(F.wave * 5 + r) * 128 + 2 * F.lane] = a[r][0]; red[(F.wave * 5 + r) * 128 + 2 * F.lane + 1] = a[r][1]; }
            __syncthreads();
            for (int i = F.tid; i < 5 * 128; i += NTHR) { const int r = i >> 7, j = i & 127; float sum = kh ? 0.f : args.in[I_BMOD][l * NMOD + (u % 96) * 128 + j];
#pragma unroll
                for (int w8 = 0; w8 < 8; ++w8) sum += red[(w8 * 5 + r) * 128 + j];
                atomicAdd(MOD + ((size_t)l * 5 + r) * NMOD + (u % 96) * 128 + j, sum); }
            __syncthreads();
        }
    }
    __syncthreads();
    { bf16* dst = (bf16*)(F.ws + WS_WPOOL); const float* src = args.in[I_POOLW]; const float* sc2 = args.in[I_PSCALE];
      for (int i = F.bid * NTHR + F.tid; i < 2 * 2048 * 512 / 4; i += F.G * NTHR) { const int e4 = i * 4, o = e4 >> 20, gc = (e4 >> 9) & 2047, d = e4 & 511;
          const f32x4 v = *(const f32x4*)(src + e4), q = *(const f32x4*)(sc2 + o * D + (gc >> 9) * 512 + d);
          v2u w; w.x = pk2(v.x * q.x, v.y * q.y); w.y = pk2(v.z * q.z, v.w * q.w); *(v2u*)(dst + e4) = w; } }
    { bf16* dst = (bf16*)(F.ws + WS_GWSB); const float* src = args.in[I_GWS];
      for (int i = F.bid * NTHR + F.tid; i < 2 * 8 * 128 * 128; i += F.G * NTHR) dst[i] = (bf16)f2bf(src[i]); }
    convert_items(F, args, 0, F.bid * NWAVES + F.wave, F.G * NWAVES);
}

__device__ __forceinline__ void unpack8(const v4u p, float (&f)[8]) {
    f[0] = bflo(p.x); f[1] = bfhi(p.x); f[2] = bflo(p.y); f[3] = bfhi(p.y); f[4] = bflo(p.z); f[5] = bfhi(p.z); f[6] = bflo(p.w); f[7] = bfhi(p.w); }
template <bool XF32>
__device__ __forceinline__ void norm_phase(Frame& F, const float* xc, const float* xs, const bf16* XB, const bf16* DL, bf16* Xout, const float* w, const float* modl, int shc, bf16* H) {
    const int gw = F.bid * NWAVES + F.wave, NGW = F.G * NWAVES;
    f32x4 fv[8], nfv[8]; v4u xv[4], nxv[4], dv[4], ndv[4];
    float wq[4][8], sq[4][8]; int ccur = -1;
#define NORM_LOAD(row_, ff, xx, dd) do { const float* xr_ = (row_) < MC ? xc + (size_t)(row_) * D : xs + (size_t)((row_) - MC) * D; \
        _Pragma("unroll") for (int j = 0; j < 4; ++j) { const int c_ = 8 * F.lane + 512 * j; \
            if (XF32) { ff[2 * j] = *(const f32x4*)(xr_ + c_); ff[2 * j + 1] = *(const f32x4*)(xr_ + c_ + 4); } else xx[j] = *(const v4u*)(XB + (size_t)(row_) * D + c_); \
            dd[j] = DL ? *(const v4u*)(DL + (size_t)(row_) * D + c_) : (v4u){0u, 0u, 0u, 0u}; } } while (0)
    int row = gw;
    if (row < M) NORM_LOAD(row, fv, xv, dv);
    for (; row < M; row += NGW) {
        const int nrow = row + NGW;
        if (nrow < M) NORM_LOAD(nrow, nfv, nxv, ndv);
        const int ci = cond_idx(row);
        if (ci != ccur) { ccur = ci; const float* mr = modl + (size_t)ci * NMOD + shc * D;
#pragma unroll
            for (int j = 0; j < 4; ++j)
#pragma unroll
                for (int h = 0; h < 2; ++h) { const int c = 8 * F.lane + 512 * j + 4 * h; const f32x4 wv = *(const f32x4*)(w + c), sh = *(const f32x4*)(mr + c), sc = *(const f32x4*)(mr + D + c);
#pragma unroll
                    for (int q = 0; q < 4; ++q) { wq[j][4 * h + q] = wv[q] * (sc[q] + 1.0f); sq[j][4 * h + q] = sh[q]; } } }
        float x[4][8]; float s = 0.f;
#pragma unroll
        for (int j = 0; j < 4; ++j) { float d[8]; unpack8(dv[j], d);
            if (XF32) {
#pragma unroll
                for (int q = 0; q < 4; ++q) { x[j][q] = fv[2 * j][q] + d[q]; x[j][4 + q] = fv[2 * j + 1][q] + d[4 + q]; } }
            else { float xx[8]; unpack8(xv[j], xx);
#pragma unroll
                for (int q = 0; q < 8; ++q) x[j][q] = xx[q] + d[q]; }
#pragma unroll
            for (int q = 0; q < 8; ++q) s += x[j][q] * x[j][q]; }
        if (Xout) {
#pragma unroll
            for (int j = 0; j < 4; ++j) { v4u o; o.x = pk2(x[j][0], x[j][1]); o.y = pk2(x[j][2], x[j][3]); o.z = pk2(x[j][4], x[j][5]); o.w = pk2(x[j][6], x[j][7]);
                __builtin_nontemporal_store(o, (v4u*)(Xout + (size_t)row * D + 8 * F.lane + 512 * j)); } }
        const float rstd = __builtin_amdgcn_rsqf(wave_sum(s) * (1.0f / D) + EPS);
#pragma unroll
        for (int j = 0; j < 4; ++j) { float y[8];
#pragma unroll
            for (int q = 0; q < 8; ++q) y[q] = x[j][q] * rstd * wq[j][q] + sq[j][q];
            v4u o; o.x = pk2(y[0], y[1]); o.y = pk2(y[2], y[3]); o.z = pk2(y[4], y[5]); o.w = pk2(y[6], y[7]);
            *(v4u*)(H + (size_t)row * D + 8 * F.lane + 512 * j) = o; }
#pragma unroll
        for (int j = 0; j < 4; ++j) { xv[j] = nxv[j]; dv[j] = ndv[j]; }
        if (XF32) {
#pragma unroll
            for (int j = 0; j < 8; ++j) fv[j] = nfv[j]; }
    }
#undef NORM_LOAD
}
__device__ __forceinline__ void final_norm_phase(Frame& F, const bf16* XB, const bf16* DL, const float* w, float* out) {
    const int gw = F.bid * NWAVES + F.wave, NGW = F.G * NWAVES;
    f32x4 wv[8];
#pragma unroll
    for (int j = 0; j < 4; ++j) { wv[2 * j] = *(const f32x4*)(w + 8 * F.lane + 512 * j); wv[2 * j + 1] = *(const f32x4*)(w + 8 * F.lane + 512 * j + 4); }
    v4u xv[4], dv[4], nxv[4], ndv[4];
#define FN_LOAD(row_, xx, dd) do { _Pragma("unroll") for (int j = 0; j < 4; ++j) { const int c_ = 8 * F.lane + 512 * j; xx[j] = *(const v4u*)(XB + (size_t)(row_) * D + c_); dd[j] = *(const v4u*)(DL + (size_t)(row_) * D + c_); } } while (0)
    int row = gw;
    if (row < M) FN_LOAD(row, xv, dv);
    for (; row < M; row += NGW) {
        const int nrow = row + NGW;
        if (nrow < M) FN_LOAD(nrow, nxv, ndv);
        float x[4][8]; float s = 0.f;
#pragma unroll
        for (int j = 0; j < 4; ++j) { float a[8], d[8]; unpack8(xv[j], a); unpack8(dv[j], d);
#pragma unroll
            for (int q = 0; q < 8; ++q) { x[j][q] = a[q] + d[q]; s += x[j][q] * x[j][q]; } }
        const float rstd = __builtin_amdgcn_rsqf(wave_sum(s) * (1.0f / D) + EPS);
#pragma unroll
        for (int j = 0; j < 4; ++j) { float* op = out + (size_t)row * D + 8 * F.lane + 512 * j;
            *(f32x4*)op = (f32x4){x[j][0], x[j][1], x[j][2], x[j][3]} * rstd * wv[2 * j]; *(f32x4*)(op + 4) = (f32x4){x[j][4], x[j][5], x[j][6], x[j][7]} * rstd * wv[2 * j + 1]; }
#pragma unroll
        for (int j = 0; j < 4; ++j) { xv[j] = nxv[j]; dv[j] = ndv[j]; }
    }
#undef FN_LOAD
}

__device__ __forceinline__ int swz(int ob) { return ob ^ (((ob >> 9) & 1) << 5); }
__device__ __forceinline__ int img_off(int r, int c, int KT) { return (((r >> 4) * KT + (c >> 5)) << 10) + swz((r & 15) * 64 + (c & 31) * 2); }
#define FRAG(base, rt, ks, KT, lsw) (*(const LAS bf16x8*)((base) + ((((rt) * (KT)) + (ks)) << 10) + (lsw)))
#define MFMA16(a, b, c) __builtin_amdgcn_mfma_f32_16x16x32_bf16((a), (b), (c), 0, 0, 0)
__device__ __forceinline__ v2u tpack(const v4u (&r)[4], int j) {
    const int d = j >> 1; const unsigned sel = (j & 1) ? 0x07060302u : 0x05040100u;
    v2u o; o.x = __builtin_amdgcn_perm(r[1][d], r[0][d], sel); o.y = __builtin_amdgcn_perm(r[3][d], r[2][d], sel); return o;
}

struct ConvW { f32x4 w0[5], w1[5], b0, b1; };
__device__ __forceinline__ ConvW conv_weights(const float* cw, const float* cb, int ch) {
    ConvW W;
#pragma unroll
    for (int k = 0; k < 5; ++k) { W.w0[k] = *(const f32x4*)(cw + k * CCONV + ch); W.w1[k] = *(const f32x4*)(cw + k * CCONV + ch + 4); }
    W.b0 = *(const f32x4*)(cb + ch); W.b1 = *(const f32x4*)(cb + ch + 4); return W;
}
__device__ __forceinline__ void conv8(const v4u (&r)[12], const ConvW& W, v4u (&out)[8]) {
#pragma unroll
    for (int i = 0; i < 8; ++i) { f32x4 a0 = W.b0, a1 = W.b1;
#pragma unroll
        for (int k = 0; k < 5; ++k) { const v4u v = r[i + k];
            a0 += W.w0[k] * (f32x4){bflo(v.x), bfhi(v.x), bflo(v.y), bfhi(v.y)}; a1 += W.w1[k] * (f32x4){bflo(v.z), bfhi(v.z), bflo(v.w), bfhi(v.w)}; }
        out[i].x = pk2(silu_f(a0.x), silu_f(a0.y)); out[i].y = pk2(silu_f(a0.z), silu_f(a0.w)); out[i].z = pk2(silu_f(a1.x), silu_f(a1.y)); out[i].w = pk2(silu_f(a1.z), silu_f(a1.w)); }
}
__device__ __forceinline__ void conv_rows12(const bf16* PROJ, int t0, int ch, v4u (&r)[12]) {
    int s0, L; if (t0 < MC) { s0 = t0 & ~255; L = 256; } else { s0 = MC + ((t0 - MC) & ~4095); L = 4096; }
#pragma unroll
    for (int j = 0; j < 12; ++j) { const int row = t0 - 2 + j; r[j] = (v4u){0u, 0u, 0u, 0u};
        if (row >= s0 && row < s0 + L) r[j] = *(const v4u*)(PROJ + (size_t)row * PROJ_LD + 6144 + ch); }
}
__device__ __forceinline__ v4u tpack8(const v4u (&o)[8], int j) {
    const int d = j >> 1; const unsigned sel = (j & 1) ? 0x07060302u : 0x05040100u;
    v4u t; t.x = __builtin_amdgcn_perm(o[1][d], o[0][d], sel); t.y = __builtin_amdgcn_perm(o[3][d], o[2][d], sel);
    t.z = __builtin_amdgcn_perm(o[5][d], o[4][d], sel); t.w = __builtin_amdgcn_perm(o[7][d], o[6][d], sel); return t;
}
__device__ __forceinline__ void bc_unit(Frame& F, int chunk, int g, const v4u (&out)[8], bf16* CSN, bf16* BTG, bf16* CBP) {
    LAS unsigned char* L = F.lds; constexpr int O_B = 0, O_C = 32768;
    const int tid = F.tid, lane = F.lane, w = F.wave, fr = lane & 15, fq = lane >> 4, lsw = swz(fr * 64 + fq * 16);
    const int cg = tid & 15, ts = (tid >> 4) & 15, isC = tid >> 8, row0 = chunk * 128;
#pragma unroll
    for (int i = 0; i < 8; ++i) *(LAS v4u*)(L + (isC ? O_C : O_B) + img_off(8 * ts + i, 8 * cg, 4)) = out[i];
    if (isC) {
#pragma unroll
        for (int i = 0; i < 8; ++i) *(v4u*)(CSN + (size_t)(row0 + 8 * ts + i) * 512 + g * 128 + 8 * cg) = out[i];
    } else {
#pragma unroll
        for (int j = 0; j < 8; ++j) *(v4u*)(BTG + ((size_t)(chunk * 4 + g) * 128 + 8 * cg + j) * 128 + 8 * ts) = tpack8(out, j);
    }
    __syncthreads();
    bf16x8 cf[4];
#pragma unroll
    for (int ks = 0; ks < 4; ++ks) cf[ks] = FRAG(L + O_C, w, ks, 4, lsw);
    v2u cbv[8];
#pragma unroll
    for (int st = 0; st < 8; ++st) { f32x4 a = (f32x4){0.f, 0.f, 0.f, 0.f};
#pragma unroll
        for (int ks = 0; ks < 4; ++ks) a = MFMA16(FRAG(L + O_B, st, ks, 4, lsw), cf[ks], a);
        cbv[st].x = pk2(a[0], a[1]); cbv[st].y = pk2(a[2], a[3]); }
    bf16* cp = CBP + ((size_t)(chunk * 4 + g) * 128 + 16 * w + fr) * 128 + fq * 32;
#pragma unroll
    for (int q = 0; q < 4; ++q) *(v4u*)(cp + 8 * q) = (v4u){cbv[2 * q].x, cbv[2 * q].y, cbv[2 * q + 1].x, cbv[2 * q + 1].y};
    __syncthreads();
}
__device__ __forceinline__ void dt_chunk(Frame& F, int chunk, const float* DT, const float* dtb, const float* alog, float* ACS, float* DTV) {
    LAS float* part = (LAS float*)(F.lds + 135168);
    const int lane = F.lane, w = F.wave, dir = lane >> 5;
    const float A = -__expf(alog[lane]), bias = dtb[lane];
    const size_t o0 = ((size_t)chunk * 128 + 16 * w) * 64 + lane;
    float raw[16], dtv[16], cs[16];
#pragma unroll
    for (int i = 0; i < 16; ++i) raw[i] = DT[o0 + (size_t)i * 64];
#pragma unroll
    for (int i = 0; i < 16; ++i) dtv[i] = softplus_f(raw[i] + bias);
    float run = 0.f;
    if (dir) {
#pragma unroll
        for (int i = 15; i >= 0; --i) { run += A * dtv[i]; cs[i] = run; }
    } else {
#pragma unroll
        for (int i = 0; i < 16; ++i) { run += A * dtv[i]; cs[i] = run; }
    }
    part[w * 64 + lane] = run;
    __syncthreads();
    float off = 0.f;
#pragma unroll
    for (int v = 0; v < 8; ++v) { const float pv = part[v * 64 + lane]; if (dir ? (v > w) : (v < w)) off += pv; }
#pragma unroll
    for (int i = 0; i < 16; ++i) { DTV[o0 + (size_t)i * 64] = dtv[i]; ACS[o0 + (size_t)i * 64] = cs[i] + off; }
    __syncthreads();
}
__device__ __forceinline__ void conv_phase(Frame& F, const bf16* PROJ, const float* DT, const float* cw, const float* cb, const float* dtb, const float* alog,
                                           bf16* CSN, bf16* BTG, bf16* CBP, bf16* XST, float* ACS, float* DTV) {
    for (int it = F.bid; it < 192; it += F.G) dt_chunk(F, it, DT, dtb, alog, ACS, DTV);
    {
        const int cg = F.tid & 15, ts = (F.tid >> 4) & 15, isC = F.tid >> 8;
        int u = F.bid;
        if (u < 768) {
            const bool sameg = (F.G & 3) == 0;
            int ch = (isC ? 2560 : 2048) + (u & 3) * 128 + 8 * cg;
            ConvW W = conv_weights(cw, cb, ch);
            v4u r[12], out[8];
            conv_rows12(PROJ, (u >> 2) * 128 + 8 * ts, ch, r);
            for (; u < 768; u += F.G) {
                const int un = u + F.G;
                conv8(r, W, out);
                if (un < 768) { if (!sameg) { ch = (isC ? 2560 : 2048) + (un & 3) * 128 + 8 * cg; W = conv_weights(cw, cb, ch); }
                    conv_rows12(PROJ, (un >> 2) * 128 + 8 * ts, ch, r); }
                bc_unit(F, u >> 2, u & 3, out, CSN, BTG, CBP);
            }
        }
    }
    {
        const int gw = F.bid * NWAVES + F.wave, NGW = F.G * NWAVES, cg = F.lane & 7, ts = F.lane >> 3;
        int it = gw;
        if (it < 12288) {
            const bool sameh = (NGW & 31) == 0;
            int ch = (it & 31) * 64 + 8 * cg;
            ConvW W = conv_weights(cw, cb, ch);
            v4u r[12], rn[12], out[8];
            conv_rows12(PROJ, (it >> 5) * 64 + 8 * ts, ch, r);
            for (; it < 12288; it += NGW) {
                const int itn = it + NGW; int chn = ch;
                if (itn < 12288) { if (!sameh) chn = (itn & 31) * 64 + 8 * cg; conv_rows12(PROJ, (itn >> 5) * 64 + 8 * ts, chn, rn); }
                conv8(r, W, out);
                const int head = it & 31, row0 = (it >> 5) * 64;
                bf16* xp = XST + ((size_t)((row0 >> 7) * 32 + head) * 64 + 8 * cg) * 128 + (row0 & 127) + 8 * ts;
#pragma unroll
                for (int j = 0; j < 8; ++j) *(v4u*)(xp + j * 128) = tpack8(out, j);
                if (itn < 12288) { if (!sameh) { ch = chn; W = conv_weights(cw, cb, ch); }
#pragma unroll
                    for (int j = 0; j < 12; ++j) r[j] = rn[j]; }
            }
        }
    }
}
__device__ __forceinline__ void gmlp_phase(Frame& F, bf16* PROJ, const float* vnorm, const bf16* wsb, const float* bs, int out_off) {
    LAS unsigned char* L = F.lds; constexpr int O_W = 0, O_V = 32768;
    const int tid = F.tid, lane = F.lane, w = F.wave, fr = lane & 15, fq = lane >> 4, lsw = swz(fr * 64 + fq * 16), cg = lane & 31;
    int u = F.bid; if (u >= 1536) return;
    const bool sameg = (F.G & 7) == 0;
    int g = u & 7, gstaged = -1;
    f32x4 nw0, nw1; float bias = 0.f;
    v4u vr[2][4], vn[2][4]; v2u uu[16], un_[16];
#define GM_LOADV(uu_, dst) do { const int row0_ = ((uu_) >> 3) * 128, g_ = (uu_) & 7; _Pragma("unroll") for (int pass = 0; pass < 2; ++pass) { const int rs_ = (tid >> 5) + 16 * pass; \
        _Pragma("unroll") for (int i = 0; i < 4; ++i) dst[pass][i] = *(const v4u*)(PROJ + (size_t)(row0_ + 4 * rs_ + i) * PROJ_LD + 2048 + g_ * 256 + 8 * cg); } } while (0)
#define GM_LOADU(uu_, dst) do { const bf16* ur_ = PROJ + (size_t)(((uu_) >> 3) * 128 + 16 * w + fr) * PROJ_LD + ((uu_) & 7) * 256 + 4 * fq; \
        _Pragma("unroll") for (int ct = 0; ct < 16; ++ct) dst[ct] = *(const v2u*)(ur_ + 16 * ct); } while (0)
    GM_LOADV(u, vr); GM_LOADU(u, uu);
    for (; u < 1536; u += F.G) {
        g = u & 7;
        if (g != gstaged) {
            if (gstaged >= 0) __syncthreads();
#pragma unroll
            for (int q = 0; q < 4; ++q) { const int idx = tid + 512 * q, t = idx >> 4, s8 = idx & 15;
                *(LAS v4u*)(L + O_W + img_off(t, 8 * s8, 4)) = *(const v4u*)(wsb + ((size_t)g * 128 + t) * 128 + 8 * s8); }
            nw0 = *(const f32x4*)(vnorm + g * 256 + 8 * cg); nw1 = *(const f32x4*)(vnorm + g * 256 + 8 * cg + 4); bias = bs[g * 128 + 16 * w + fr]; gstaged = g; }
#pragma unroll
        for (int pass = 0; pass < 2; ++pass) { const int rs = (tid >> 5) + 16 * pass;
            float x[4][8], rstd[4];
#pragma unroll
            for (int i = 0; i < 4; ++i) { float q = 0.f;
#pragma unroll
                for (int d = 0; d < 4; ++d) { x[i][2 * d] = bflo(vr[pass][i][d]); x[i][2 * d + 1] = bfhi(vr[pass][i][d]); q += x[i][2 * d] * x[i][2 * d] + x[i][2 * d + 1] * x[i][2 * d + 1]; }
                q += __shfl_xor(q, 1); q += __shfl_xor(q, 2); q += __shfl_xor(q, 4); q += __shfl_xor(q, 8); q += __shfl_xor(q, 16);
                rstd[i] = __builtin_amdgcn_rsqf(q * (1.0f / 256.f) + EPS); }
#pragma unroll
            for (int j = 0; j < 8; ++j) { const float nw = j < 4 ? nw0[j & 3] : nw1[j & 3];
                v2u o; o.x = pk2(x[0][j] * rstd[0] * nw, x[1][j] * rstd[1] * nw); o.y = pk2(x[2][j] * rstd[2] * nw, x[3][j] * rstd[3] * nw);
                *(LAS v2u*)(L + O_V + img_off(8 * cg + j, 4 * rs, 4)) = o; }
        }
        __syncthreads();
        const int un = u + F.G;
        if (un < 1536) { GM_LOADV(un, vn); GM_LOADU(un, un_); }
        bf16* urow = PROJ + (size_t)((u >> 3) * 128 + 16 * w + fr) * PROJ_LD + g * 256 + 4 * fq;
        bf16x8 af[4];
#pragma unroll
        for (int ks = 0; ks < 4; ++ks) af[ks] = FRAG(L + O_W, w, ks, 4, lsw);
#pragma unroll
        for (int ct = 0; ct < 16; ++ct) { f32x4 a = (f32x4){0.f, 0.f, 0.f, 0.f};
#pragma unroll
            for (int ks = 0; ks < 4; ++ks) a = MFMA16(FRAG(L + O_V, ct, ks, 4, lsw), af[ks], a);
            v2u o; o.x = pk2((a[0] + bias) * bflo(uu[ct].x), (a[1] + bias) * bfhi(uu[ct].x)); o.y = pk2((a[2] + bias) * bflo(uu[ct].y), (a[3] + bias) * bfhi(uu[ct].y));
            *(v2u*)(urow + out_off + 16 * ct) = o; }
        __syncthreads();
        if (un < 1536) {
#pragma unroll
            for (int pass = 0; pass < 2; ++pass)
#pragma unroll
                for (int i = 0; i < 4; ++i) vr[pass][i] = vn[pass][i];
#pragma unroll
            for (int ct = 0; ct < 16; ++ct) uu[ct] = un_[ct]; }
    }
    (void)sameg;
#undef GM_LOADV
#undef GM_LOADU
}

template <int DIR>
__device__ __forceinline__ void ssd_unit(Frame& F, int seq_row0, int nchunks, int head, const float* h0, float* hfin,
                                         const bf16* CSN, const bf16* BTG, const bf16* XST, const bf16* CBP, const float* ACS, const float* DTV, float dskip, bf16* Y) {
    LAS unsigned char* L = F.lds;
    constexpr int dir = DIR;
    constexpr int O_CS = 0, O_BT = 32768, O_XT = 65536, O_HS = 81920, O_E = 98304, O_DT = O_E + 512, O_WG = O_DT + 512, O_V = O_WG + 512, O_R = O_V + 512;
    const int tid = F.tid, lane = F.lane, w = F.wave, fr = lane & 15, fq = lane >> 4;
    const int lsw = swz(fr * 64 + fq * 16), lsw1 = swz(fr * 64 + fq * 8), lsw2 = swz(fr * 64 + 32 + fq * 8);
    const int g = head >> 3, col = dir * 32 + head, last = dir ? 0 : 127;
    const int cgB = tid & 15, rsB = tid >> 4, lidx = 16 * w + fr;
    f32x4 Hacc[4];
#pragma unroll
    for (int pt = 0; pt < 4; ++pt) Hacc[pt] = h0 ? *(const f32x4*)(h0 + (16 * pt + fr) * 128 + 16 * w + 4 * fq) : (f32x4){0.f, 0.f, 0.f, 0.f};
    v4u rc[4], rbt[4], rx[2], rcb[4]; float rE = 0.f, rD = 0.f, rEl = 0.f;
#pragma unroll
    for (int q = 0; q < 4; ++q) rcb[q] = (v4u){0u, 0u, 0u, 0u};
#define SSD_LOADS(cc) do { const size_t r0_ = (size_t)seq_row0 + (size_t)(cc) * 128, ck_ = r0_ >> 7; \
        _Pragma("unroll") for (int i = 0; i < 4; ++i) rc[i] = *(const v4u*)(CSN + (r0_ + 4 * rsB + i) * 512 + g * 128 + 8 * cgB); \
        _Pragma("unroll") for (int q = 0; q < 4; ++q) rbt[q] = *(const v4u*)(BTG + (ck_ * 4 + g) * 16384 + (size_t)(tid + 512 * q) * 8); \
        _Pragma("unroll") for (int q = 0; q < 2; ++q) rx[q] = *(const v4u*)(XST + (ck_ * 32 + head) * 8192 + (size_t)(tid + 512 * q) * 8); \
        _Pragma("unroll") for (int q = 0; q < 4; ++q) { if (dir ? (2 * q + 1 >= w) : (2 * q <= w)) rcb[q] = *(const v4u*)(CBP + ((ck_ * 4 + g) * 128 + lidx) * 128 + fq * 32 + 8 * q); } \
        if (tid < 128) { rE = ACS[(r0_ + tid) * 64 + col]; rD = DTV[(r0_ + tid) * 64 + col]; rEl = ACS[(r0_ + last) * 64 + col]; } } while (0)
#define SSD_WRITE_HS() do { _Pragma("unroll") for (int pt = 0; pt < 4; ++pt) { v2u o_; o_.x = pk2(Hacc[pt][0], Hacc[pt][1]); o_.y = pk2(Hacc[pt][2], Hacc[pt][3]); \
        *(LAS v2u*)(L + O_HS + img_off(16 * pt + fr, 16 * w + 4 * fq, 4)) = o_; } } while (0)
    float dmask[4], dsk[4];
#pragma unroll
    for (int j = 0; j < 4; ++j) { const int sj = 4 * fq + j; dmask[j] = (dir ? (sj < fr) : (sj > fr)) ? 0.f : 1.f; dsk[j] = (!dir && sj == fr) ? dskip : 0.f; }
    int c = dir ? nchunks - 1 : 0;
    SSD_LOADS(c);
    SSD_WRITE_HS();
    for (int step = 0; step < nchunks; ++step) {
        const size_t row0 = (size_t)seq_row0 + (size_t)c * 128;
#pragma unroll
        for (int i = 0; i < 4; ++i) *(LAS v4u*)(L + O_CS + img_off(4 * rsB + i, 8 * cgB, 4)) = rc[i];
#pragma unroll
        for (int q = 0; q < 4; ++q) { const int idx = tid + 512 * q; *(LAS v4u*)(L + O_BT + img_off(idx >> 4, 8 * (idx & 15), 4)) = rbt[q]; }
#pragma unroll
        for (int q = 0; q < 2; ++q) { const int idx = tid + 512 * q; *(LAS v4u*)(L + O_XT + img_off(idx >> 4, 8 * (idx & 15), 4)) = rx[q]; }
        if (tid < 128) {
            const int refl = (lane & 48) | (dir ? 0 : 15);
            const float Rt = __shfl(rE, refl);
            *(LAS float*)(L + O_E + 4 * tid) = rE; *(LAS float*)(L + O_DT + 4 * tid) = rD; *(LAS float*)(L + O_WG + 4 * tid) = rD * __expf(rEl - rE);
            *(LAS float*)(L + O_V + 4 * tid) = rD * __expf(Rt - rE);
            if (lane == refl) *(LAS float*)(L + O_R + 4 * (tid >> 4)) = rE; }
        __syncthreads();
        const float El = *(const LAS float*)(L + O_E + 4 * lidx);
        v2u Mr[8];
        const f32x4 R0 = *(const LAS f32x4*)(L + O_R), R1 = *(const LAS f32x4*)(L + O_R + 16);
        const float Rst[8] = {R0[0], R0[1], R0[2], R0[3], R1[0], R1[1], R1[2], R1[3]};
        f32x4 Vv[8];
#pragma unroll
        for (int st = 0; st < 8; ++st) Vv[st] = *(const LAS f32x4*)(L + O_V + 4 * (16 * st + 4 * fq));
        const f32x4 Esd = *(const LAS f32x4*)(L + O_E + 4 * (16 * w + 4 * fq)), dsd = *(const LAS f32x4*)(L + O_DT + 4 * (16 * w + 4 * fq));
        __builtin_amdgcn_sched_barrier(0);
#pragma unroll
        for (int st = 0; st < 8; ++st) {
            Mr[st] = (v2u){0u, 0u};
            if (dir ? (st >= w) : (st <= w)) {
                const unsigned clo = rcb[st >> 1][(st & 1) * 2], chi = rcb[st >> 1][(st & 1) * 2 + 1];
                float m[4] = {bflo(clo), bfhi(clo), bflo(chi), bfhi(chi)};
                if (st == w) {
                    asm volatile("" ::: "memory");
#pragma unroll
                    for (int j = 0; j < 4; ++j) m[j] = m[j] * (__expf(dmask[j] != 0.f ? El - Esd[j] : 0.f) * dsd[j] * dmask[j]) + dsk[j];
                } else {
                    const float u = __expf(El - Rst[st]);
#pragma unroll
                    for (int j = 0; j < 4; ++j) m[j] = m[j] * (u * Vv[st][j]);
                }
                Mr[st].x = pk2(m[0], m[1]); Mr[st].y = pk2(m[2], m[3]);
            }
        }
        __builtin_amdgcn_sched_barrier(0);
        bf16x8 cf[4], hf[16];
#pragma unroll
        for (int ks = 0; ks < 4; ++ks) cf[ks] = FRAG(L + O_CS, w, ks, 4, lsw);
#pragma unroll
        for (int pt = 0; pt < 4; ++pt)
#pragma unroll
            for (int ks = 0; ks < 4; ++ks) hf[pt * 4 + ks] = FRAG(L + O_HS, pt, ks, 4, lsw);
        const int cn = dir ? c - 1 : c + 1;
        if (step + 1 < nchunks) SSD_LOADS(cn);
        __builtin_amdgcn_sched_barrier(0);
        f32x4 Yv[4];
#pragma unroll
        for (int pt = 0; pt < 4; ++pt) { Yv[pt] = (f32x4){0.f, 0.f, 0.f, 0.f};
#pragma unroll
            for (int ks = 0; ks < 4; ++ks) Yv[pt] = MFMA16(hf[pt * 4 + ks], cf[ks], Yv[pt]); }
        __builtin_amdgcn_sched_barrier(0);
        { const float sc = __expf(El);
#pragma unroll
          for (int pt = 0; pt < 4; ++pt) Yv[pt] *= sc; }
#pragma unroll
        for (int kh = 0; kh < 2; ++kh) {
            v4u xq[8];
#pragma unroll
            for (int k2 = 0; k2 < 2; ++k2)
#pragma unroll
                for (int pt = 0; pt < 4; ++pt) { const LAS unsigned char* xb = L + O_XT + ((pt * 4 + 2 * kh + k2) << 10); xq[k2 * 4 + pt].xy = *(const LAS v2u*)(xb + lsw1); xq[k2 * 4 + pt].zw = *(const LAS v2u*)(xb + lsw2); }
            __builtin_amdgcn_sched_barrier(0);
#pragma unroll
            for (int k2 = 0; k2 < 2; ++k2) { const int ks = 2 * kh + k2;
                if (dir ? (2 * ks + 1 >= w) : (2 * ks <= w)) {
                    const v4u mv = (v4u){Mr[2 * ks].x, Mr[2 * ks].y, Mr[2 * ks + 1].x, Mr[2 * ks + 1].y};
                    const bf16x8 mf = __builtin_bit_cast(bf16x8, mv);
#pragma unroll
                    for (int pt = 0; pt < 4; ++pt) Yv[pt] = MFMA16(__builtin_bit_cast(bf16x8, xq[k2 * 4 + pt]), mf, Yv[pt]);
                } }
            __builtin_amdgcn_sched_barrier(0);
        }
        __builtin_amdgcn_sched_barrier(0);
        bf16x8 bfr[4];
        { v4u bv[4]; f32x4 g0[4], g1[4];
#pragma unroll
          for (int ks = 0; ks < 4; ++ks) { bv[ks] = __builtin_bit_cast(v4u, FRAG(L + O_BT, w, ks, 4, lsw));
              g0[ks] = *(const LAS f32x4*)(L + O_WG + 4 * (32 * ks + 8 * fq)); g1[ks] = *(const LAS f32x4*)(L + O_WG + 4 * (32 * ks + 8 * fq + 4)); }
          __builtin_amdgcn_sched_barrier(0);
#pragma unroll
          for (int ks = 0; ks < 4; ++ks) { v4u b = bv[ks];
              b.x = pk2(bflo(b.x) * g0[ks][0], bfhi(b.x) * g0[ks][1]); b.y = pk2(bflo(b.y) * g0[ks][2], bfhi(b.y) * g0[ks][3]);
              b.z = pk2(bflo(b.z) * g1[ks][0], bfhi(b.z) * g1[ks][1]); b.w = pk2(bflo(b.w) * g1[ks][2], bfhi(b.w) * g1[ks][3]);
              bfr[ks] = __builtin_bit_cast(bf16x8, b); } }
        __builtin_amdgcn_sched_barrier(0);
        bf16x8 xf[16];
#pragma unroll
        for (int ks = 0; ks < 4; ++ks)
#pragma unroll
            for (int pt = 0; pt < 4; ++pt) xf[ks * 4 + pt] = FRAG(L + O_XT, pt, ks, 4, lsw);
        const float dec = __expf(*(const LAS float*)(L + O_E + 4 * last));
#pragma unroll
        for (int pt = 0; pt < 4; ++pt) { v2u o; o.x = pk2(Yv[pt][0], Yv[pt][1]); o.y = pk2(Yv[pt][2], Yv[pt][3]);
            *(v2u*)(Y + (row0 + lidx) * D + head * 64 + 16 * pt + 4 * fq) = o; }
        __builtin_amdgcn_sched_barrier(0);
#pragma unroll
        for (int pt = 0; pt < 4; ++pt) Hacc[pt] *= dec;
#pragma unroll
        for (int ks = 0; ks < 4; ++ks)
#pragma unroll
            for (int pt = 0; pt < 4; ++pt) Hacc[pt] = MFMA16(bfr[ks], xf[ks * 4 + pt], Hacc[pt]);
        __syncthreads();
        SSD_WRITE_HS();
        c = cn;
    }
    if (hfin) {
#pragma unroll
        for (int pt = 0; pt < 4; ++pt) *(f32x4*)(hfin + (16 * pt + fr) * 128 + 16 * w + 4 * fq) = Hacc[pt]; }
    __syncthreads();
#undef SSD_LOADS
#undef SSD_WRITE_HS
}

__device__ __forceinline__ void ssd_combine_phase(Frame& F, const bf16* YF, const bf16* YB, bf16* PROJ, const float* nw) {
    const int gw = F.bid * NWAVES + F.wave, NGW = F.G * NWAVES;
    v4u a[4], b[4], z[4], na[4], nb[4], nz[4];
    f32x4 nwv[8];
#pragma unroll
    for (int j = 0; j < 4; ++j) { nwv[2 * j] = *(const f32x4*)(nw + 8 * F.lane + 512 * j); nwv[2 * j + 1] = *(const f32x4*)(nw + 8 * F.lane + 512 * j + 4); }
#define CMB_LOAD(row_, aa, bb, zz) do { _Pragma("unroll") for (int j = 0; j < 4; ++j) { const int c_ = 8 * F.lane + 512 * j; \
        aa[j] = *(const v4u*)(YF + (size_t)(row_) * D + c_); bb[j] = *(const v4u*)(YB + (size_t)(row_) * D + c_); zz[j] = *(const v4u*)(PROJ + (size_t)(row_) * PROJ_LD + 4096 + c_); } } while (0)
    int row = gw;
    if (row < M) CMB_LOAD(row, a, b, z);
    for (; row < M; row += NGW) {
        const int nrow = row + NGW;
        if (nrow < M) CMB_LOAD(nrow, na, nb, nz);
        float y[32]; float s = 0.f;
#pragma unroll
        for (int j = 0; j < 4; ++j) {
#pragma unroll
            for (int q = 0; q < 4; ++q) { const float lo = (bflo(a[j][q]) + bflo(b[j][q])) * bflo(z[j][q]), hi = (bfhi(a[j][q]) + bfhi(b[j][q])) * bfhi(z[j][q]);
                y[8 * j + 2 * q] = lo; y[8 * j + 2 * q + 1] = hi; s += lo * lo + hi * hi; } }
        const float rstd = __builtin_amdgcn_rsqf(wave_sum(s) * (1.0f / D) + EPS);
#pragma unroll
        for (int j = 0; j < 4; ++j) { const int c = 8 * F.lane + 512 * j; const f32x4 w0 = nwv[2 * j], w1 = nwv[2 * j + 1];
            v4u o; o.x = pk2(y[8 * j] * rstd * w0.x, y[8 * j + 1] * rstd * w0.y); o.y = pk2(y[8 * j + 2] * rstd * w0.z, y[8 * j + 3] * rstd * w0.w);
            o.z = pk2(y[8 * j + 4] * rstd * w1.x, y[8 * j + 5] * rstd * w1.y); o.w = pk2(y[8 * j + 6] * rstd * w1.z, y[8 * j + 7] * rstd * w1.w);
            *(v4u*)(PROJ + (size_t)row * PROJ_LD + 2048 + c) = o; }
#pragma unroll
        for (int j = 0; j < 4; ++j) { a[j] = na[j]; b[j] = nb[j]; z[j] = nz[j]; }
    }
#undef CMB_LOAD
}

template <int K>
__device__ __forceinline__ void pool_run(int r0, int a0, int W, int ch, const bf16* HC, bf16* PL) {
    constexpr int NR = 8 + K - 1;
    v4u r[NR], nx[8];
#define POOL_ROW(dst, row_) do { const int rr_ = (row_); dst = (v4u){0u, 0u, 0u, 0u}; if (rr_ >= a0 && rr_ < a0 + W) dst = *(const v4u*)(HC + (size_t)rr_ * D + ch); } while (0)
#pragma unroll
    for (int j = 0; j < NR; ++j) POOL_ROW(r[j], r0 - K / 2 + j);
#pragma unroll
    for (int blk = 0; blk < 2; ++blk) {
        const int t0 = r0 + 8 * blk;
        if (blk == 0) {
#pragma unroll
            for (int i = 0; i < 8; ++i) POOL_ROW(nx[i], t0 - K / 2 + NR + i); }
        float s[8] = {0.f, 0.f, 0.f, 0.f, 0.f, 0.f, 0.f, 0.f};
#pragma unroll
        for (int j = 0; j < K; ++j) {
#pragma unroll
            for (int q = 0; q < 4; ++q) { s[2 * q] += bflo(r[j][q]); s[2 * q + 1] += bfhi(r[j][q]); } }
#pragma unroll
        for (int i = 0; i < 8; ++i) {
            if (i > 0) {
#pragma unroll
                for (int q = 0; q < 4; ++q) { s[2 * q] += bflo(r[i + K - 1][q]) - bflo(r[i - 1][q]); s[2 * q + 1] += bfhi(r[i + K - 1][q]) - bfhi(r[i - 1][q]); } }
            const int t = t0 + i - a0; int lo = t - K / 2; if (lo < 0) lo = 0; int hi = t - K / 2 + K; if (hi > W) hi = W;
            const float inv = 1.0f / (float)(hi - lo);
            const v4u x = r[i + K / 2]; v4u o;
#pragma unroll
            for (int q = 0; q < 4; ++q) o[q] = pk2(s[2 * q] * inv - bflo(x[q]), s[2 * q + 1] * inv - bfhi(x[q]));
            *(v4u*)(PL + (size_t)(t0 + i) * D + ch) = o; }
        if (blk == 0) {
#pragma unroll
            for (int j = 0; j < NR - 8; ++j) r[j] = r[j + 8];
#pragma unroll
            for (int i = 0; i < 8; ++i) r[NR - 8 + i] = nx[i]; }
    }
#undef POOL_ROW
}
__device__ __forceinline__ void pool_phase(Frame& F, const bf16* HC, bf16* PL) {
    const int gw = F.bid * NWAVES + F.wave, NGW = F.G * NWAVES;
    for (int it = gw; it < (M / 16) * 4; it += NGW) {
        const int g = it & 3, r0 = (it >> 2) * 16, ch = g * 512 + 8 * F.lane;
        int a0, W; if (r0 < MC) { a0 = r0 & ~255; W = 256; } else { a0 = r0 & ~63; W = 64; }
        if (g == 0) pool_run<2>(r0, a0, W, ch, HC, PL); else if (g == 1) pool_run<4>(r0, a0, W, ch, HC, PL);
        else if (g == 2) pool_run<8>(r0, a0, W, ch, HC, PL); else pool_run<16>(r0, a0, W, ch, HC, PL);
    }
}

constexpr int NPHASES = 39;
#define WSP(T, off) ((T*)(ws + (off)))
__global__ void __launch_bounds__(NTHR, 2) mega_fwd(Args args_by_value) {
    extern __shared__ __attribute__((aligned(16))) unsigned char lds[];
    int lo, hi;
    XcdBarrier bar;
    { CArgs* A = kargs(0); lo = A->ph_lo; hi = A->ph_hi;
      if (threadIdx.x < 64) ((LAS unsigned*)((LAS unsigned char*)lds + MISC_OFF))[threadIdx.x] = 0u;
      __syncthreads();
      bar = xcd_barrier_post((unsigned*)(A->ws + WS_CTL) + CW_BAR + A->li * XCD_BAR_WORDS, (volatile LAS unsigned*)((LAS unsigned char*)lds + MISC_OFF) + 8); }
#define IN(k) (lo <= (k) && (k) < hi)
#define SEAM(k) do { if (IN((k) + 1)) { xcd_barrier(bar); if (PROBE_REP_MASK & 256) xcd_barrier(bar); } } while (0)
#define REP_BEGIN(bit) _Pragma("unroll") for (int rep_ = 0; rep_ < (((PROBE_REP_MASK) >> (bit)) & 1) + 1; ++rep_) { if (rep_) xcd_barrier(bar);
#define REP_END }

    if (IN(0)) { REP_BEGIN(0) CArgs* A = kargs(0); Frame F = mkframe(A); p0_prologue(F, *A); REP_END SEAM(0); }
    if (IN(1)) { CArgs* A = kargs(1); Frame F = mkframe(A); unsigned char* ws = A->ws;
        pg8::Gemm g{WSP(const bf16, WS_WOUTO), WSP(const bf16, WS_WPOOL), 2 * D, D, 512, D, 2, 8}; pg8::StaticOrder S; S.init(2 * D, D, F.G, F.bid);
        pg8::EpiBf16 E{WSP(bf16, WS_W2T), D, nullptr};
        pg8::gemm_phase<pg8::EpiBf16, pg8::StaticOrder, true, true>(F.lds, g, S, E);
        SEAM(1);
    }

    for (int l = 0; l < DEPTH; ++l) {
        const int pb = 2 + 9 * l, e = l >> 1;
        if (IN(pb + 0)) { CArgs* A = kargs(pb); Frame F = mkframe(A); unsigned char* ws = A->ws; bf16* XB = WSP(bf16, WS_X);
            if (l == 0) norm_phase<true>(F, A->in[I_XP], A->in[I_XS], nullptr, nullptr, nullptr, A->in[I_NMIX] + l * D, WSP(const float, WS_MOD) + (size_t)l * 5 * NMOD, 0, WSP(bf16, WS_H));
            else norm_phase<false>(F, nullptr, nullptr, XB, WSP(const bf16, WS_DELTA), XB, A->in[I_NMIX] + l * D, WSP(const float, WS_MOD) + (size_t)l * 5 * NMOD, 0, WSP(bf16, WS_H));
            SEAM(pb + 0); }
        if ((l & 1) == 0) {
            if (IN(pb + 1)) { REP_BEGIN(2) CArgs* A = kargs(pb + 1); Frame F = mkframe(A); unsigned char* ws = A->ws;
                pg8::Gemm g{WSP(bf16, WS_H), WSP(const bf16, WS_WINE) + (size_t)e * IN_PAD * D, M, IN_PAD, D, D, 0, 0}; pg8::StaticOrder S; S.init(M, IN_PAD, F.G, F.bid);
                pg8::EpiInEven E{WSP(bf16, WS_PROJ), WSP(float, WS_DT)};
                pg8::gemm_phase<pg8::EpiInEven, pg8::StaticOrder, true, true>(F.lds, g, S, E);
                REP_END SEAM(pb + 1);
            }
            if (IN(pb + 2)) {
                REP_BEGIN(3)
                { CArgs* A = kargs(pb + 2); Frame F = mkframe(A); unsigned char* ws = A->ws;
                  conv_phase(F, WSP(const bf16, WS_PROJ), WSP(const float, WS_DT), A->in[I_CONVW] + (size_t)e * 5 * CCONV, A->in[I_CONVB] + (size_t)e * CCONV, A->in[I_DTB] + e * 64, A->in[I_ALOG] + e * 64,
                             WSP(bf16, WS_CSN), WSP(bf16, WS_BTG), WSP(bf16, WS_CBP), WSP(bf16, WS_XST), WSP(float, WS_ACS), WSP(float, WS_DTV)); }
                REP_END
                _Pragma("unroll") for (int rep_ = 0; rep_ < (((PROBE_REP_MASK) >> 13) & 1) + 1; ++rep_) { if (rep_) xcd_barrier(bar);
                { CArgs* A = kargs(pb + 2 + rep_); Frame F = mkframe(A); unsigned char* ws = A->ws;
                  gmlp_phase(F, WSP(bf16, WS_PROJ), A->in[I_GNORM] + e * D, WSP(const bf16, WS_GWSB) + (size_t)e * 8 * 128 * 128, A->in[I_GBS] + e * 8 * 128, rep_ ? 2048 : 0); } }
                SEAM(pb + 2);
            }
            if (IN(pb + 3)) {
                REP_BEGIN(4) for (int u = blockIdx.x; u < 2304; u += gridDim.x) { CArgs* A = kargs(u); Frame F = mkframe(A); unsigned char* ws = A->ws;
                    int b, head, dir, k;
                    if (F.G == 256) { k = u >> 8; const int x = F.bid & 7, combo = (k == 0 ? 0 : (k - 1) * 8) + x; b = combo >> 1; dir = combo & 1; head = F.bid >> 3; }
                    else { k = u < 256 ? 0 : 1; const int v = k == 0 ? u : u - 256; b = v >> 6; head = (v >> 1) & 31; dir = v & 1; }
                    int seq0, nch; const float* h0 = nullptr; float* hf = nullptr;
                    if (k == 0) { seq0 = MC + b * SEQ_S; nch = SEQ_S / 128; h0 = A->in[I_STATE] + ((((size_t)b * 2 + e) * 2 + dir) * NH + head) * (HP * NST); }
                    else { seq0 = b * SEQ_C; nch = SEQ_C / 128; hf = A->out + (size_t)M * D + ((((size_t)b * 2 + e) * 2 + dir) * NH + head) * (HP * NST); }
                    if (dir) ssd_unit<1>(F, seq0, nch, head, h0, hf, WSP(const bf16, WS_CSN), WSP(const bf16, WS_BTG), WSP(const bf16, WS_XST), WSP(const bf16, WS_CBP), WSP(const float, WS_ACS), WSP(const float, WS_DTV), 0.f, WSP(bf16, WS_YB));
                    else ssd_unit<0>(F, seq0, nch, head, h0, hf, WSP(const bf16, WS_CSN), WSP(const bf16, WS_BTG), WSP(const bf16, WS_XST), WSP(const bf16, WS_CBP), WSP(const float, WS_ACS), WSP(const float, WS_DTV), A->in[I_SSDD][e * NH + head], WSP(bf16, WS_YF));
                } REP_END
                SEAM(pb + 3);
            }
            if (IN(pb + 4)) { REP_BEGIN(5) CArgs* A = kargs(pb + 4); Frame F = mkframe(A); unsigned char* ws = A->ws;
                ssd_combine_phase(F, WSP(const bf16, WS_YF), WSP(const bf16, WS_YB), WSP(bf16, WS_PROJ), A->in[I_SNORM] + e * D); REP_END SEAM(pb + 4); }
        } else {
            if (IN(pb + 1)) { REP_BEGIN(9) CArgs* A = kargs(pb + 1); Frame F = mkframe(A); unsigned char* ws = A->ws;
                pg8::Gemm g{WSP(bf16, WS_H), WSP(const bf16, WS_WINO) + (size_t)e * D * D, M, D, D, D, 0, 0}; pg8::StaticOrder S; S.init(M, D, F.G, F.bid, 4);
                pg8::EpiBf16 E{WSP(bf16, WS_HC), D, nullptr};
                pg8::gemm_phase<pg8::EpiBf16, pg8::StaticOrder, true, true>(F.lds, g, S, E);
                REP_END SEAM(pb + 1);
            }
            if (IN(pb + 2)) { REP_BEGIN(6) CArgs* A = kargs(pb + 2); Frame F = mkframe(A); unsigned char* ws = A->ws; pool_phase(F, WSP(const bf16, WS_HC), WSP(bf16, WS_PL)); REP_END SEAM(pb + 2); }
        }
        if (IN(pb + 5)) { REP_BEGIN(11) CArgs* A = kargs(pb + 5); Frame F = mkframe(A); unsigned char* ws = A->ws;
            const bool ev = (l & 1) == 0;
            pg8::Gemm g{ev ? WSP(const bf16, WS_PROJ) : WSP(const bf16, WS_PL), ev ? WSP(const bf16, WS_WOUTE) + (size_t)e * D * 4096 : WSP(const bf16, WS_W2T) + (size_t)e * D * D, M, D, ev ? 4096 : D, ev ? PROJ_LD : D, 0, 0};
            pg8::StaticOrder S; S.init(M, D, F.G, F.bid, 4);
            pg8::EpiDelta E{WSP(bf16, WS_DELTA), WSP(const float, WS_MOD) + (size_t)l * 5 * NMOD + 2 * D};
            pg8::gemm_phase<pg8::EpiDelta, pg8::StaticOrder, true, true>(F.lds, g, S, E);
            REP_END SEAM(pb + 5);
        }
        if (IN(pb + 6)) { CArgs* A = kargs(pb + 6); Frame F = mkframe(A); unsigned char* ws = A->ws; bf16* XB = WSP(bf16, WS_X);
            if (l == 0) norm_phase<true>(F, A->in[I_XP], A->in[I_XS], nullptr, WSP(const bf16, WS_DELTA), XB, A->in[I_NFFN] + l * D, WSP(const float, WS_MOD) + (size_t)l * 5 * NMOD, 3, WSP(bf16, WS_H));
            else norm_phase<false>(F, nullptr, nullptr, XB, WSP(const bf16, WS_DELTA), XB, A->in[I_NFFN] + l * D, WSP(const float, WS_MOD) + (size_t)l * 5 * NMOD, 3, WSP(bf16, WS_H));
            SEAM(pb + 6); }
        if (IN(pb + 7)) { REP_BEGIN(7) CArgs* A = kargs(pb + 7); Frame F = mkframe(A); unsigned char* ws = A->ws;
            pg8::Gemm g{WSP(bf16, WS_H), WSP(const bf16, WS_WUP) + (size_t)l * NFU * D, M, NFU, D, D, 0, 0}; pg8::StaticOrder S; S.init(M, NFU, F.G, F.bid);
            pg8::EpiFfnUp E{WSP(bf16, WS_G)};
            pg8::gemm_phase<pg8::EpiFfnUp, pg8::StaticOrder, true, true>(F.lds, g, S, E);
            REP_END
            {
                CArgs* A = kargs(pb + 7); Frame F = mkframe(A);
                const int nwg = (M / 256) * (NFU / 256), busy = nwg % F.G;
                if (busy == 0) convert_items(F, *A, 1 + l, F.bid * NWAVES + F.wave, F.G * NWAVES);
                else if (F.bid >= busy) convert_items(F, *A, 1 + l, (F.bid - busy) * NWAVES + F.wave, (F.G - busy) * NWAVES);
            }
            SEAM(pb + 7);
        }
        if (IN(pb + 8)) { REP_BEGIN(12) CArgs* A = kargs(pb + 8); Frame F = mkframe(A); unsigned char* ws = A->ws;
            pg8::Gemm g{WSP(bf16, WS_G), WSP(const bf16, WS_WDN) + (size_t)l * D * FF, M, D, FF, FF, 0, 0}; pg8::StaticOrder S; S.init(M, D, F.G, F.bid, 4);
            pg8::EpiDelta E{WSP(bf16, WS_DELTA), WSP(const float, WS_MOD) + (size_t)l * 5 * NMOD + 5 * D};
            pg8::gemm_phase<pg8::EpiDelta, pg8::StaticOrder, true, true>(F.lds, g, S, E);
            REP_END SEAM(pb + 8);
        }
    }
    if (IN(38)) { CArgs* A = kargs(38); Frame F = mkframe(A); unsigned char* ws = A->ws; final_norm_phase(F, WSP(const bf16, WS_X), WSP(const bf16, WS_DELTA), A->in[I_FNORM], A->out); }
#undef IN
#undef SEAM
}

extern "C" void kernel_launch(void* const* d_in, const int* in_sizes, int n_in, void* d_out, int out_size, void* d_ws, size_t ws_size, hipStream_t stream) {
    static int grid = 0;
    if (grid == 0) {
        if (n_in != 28 || ws_size < WS_END) { fprintf(stderr, "kernel_launch: unexpected n_in %d / ws_size %zu (need %zu)\n", n_in, ws_size, (size_t)WS_END); grid = -1; return; }
        int dev = 0, cus = 0, per_cu = 0;
        if (hipGetDevice(&dev) != hipSuccess || hipDeviceGetAttribute(&cus, hipDeviceAttributeMultiprocessorCount, dev) != hipSuccess) { grid = -1; return; }
        if (hipFuncSetAttribute((const void*)mega_fwd, hipFuncAttributeMaxDynamicSharedMemorySize, LDS_BYTES) != hipSuccess) { fprintf(stderr, "kernel_launch: hipFuncSetAttribute failed\n"); grid = -1; return; }
        if (hipOccupancyMaxActiveBlocksPerMultiprocessor(&per_cu, (const void*)mega_fwd, NTHR, LDS_BYTES) != hipSuccess || per_cu < 1) fprintf(stderr, "kernel_launch: occupancy query says %d\n", per_cu);
        (void)hipGetLastError();
        grid = cus;
    }
    if (grid < 0) return;
    if (hipMemsetAsync((char*)d_ws + WS_CTL, 0, CTL_ZERO_BYTES, stream) != hipSuccess) return;
    Args a{};
    for (int i = 0; i < 28; ++i) a.in[i] = (const float*)d_in[i];
    a.out = (float*)d_out; a.ws = (unsigned char*)d_ws; a.pad = 0;
#if MK_PER_PHASE
    for (int ph = 0; ph < NPHASES; ++ph) { a.ph_lo = ph; a.ph_hi = ph + 1; a.li = 0;
        hipLaunchKernelGGL(mega_fwd, dim3(grid), dim3(NTHR), LDS_BYTES, stream, a); }
#else
    a.ph_lo = 0; a.ph_hi = NPHASES; a.li = 0;
    hipLaunchKernelGGL(mega_fwd, dim3(grid), dim3(NTHR), LDS_BYTES, stream, a);
#endif
}
```

```cpp
#include <hip/hip_runtime.h>
#include <cstdio>
#include <cstdint>

#ifndef PROBE_REP_MASK
#define PROBE_REP_MASK 0
#endif
#ifndef MK_PER_PHASE
#define MK_PER_PHASE 0
#endif

constexpr int D = 2048, MC = 8192, MS = 16384, M = MC + MS, DEPTH = 4, FF = 5632, NFU = 2 * FF;
constexpr int IN_EVEN = 9280, IN_PAD = 9472, PROJ_LD = 9216, CCONV = 3072;
constexpr int NH = 32, HP = 64, NST = 128;
constexpr int SEQ_C = 256, NB_C = 32, SEQ_S = 4096, NB_S = 4;
constexpr int NMOD = 6 * D;
constexpr float EPS = 1e-6f;
constexpr int NWAVES = 8, NTHR = 512;

constexpr size_t MiB = 1u << 20;
constexpr size_t WS_CTL = 0, CTL_ZERO_BYTES = 2 * MiB;
constexpr size_t WS_MOD = 1 * MiB;
constexpr size_t WS_WINE = 4 * MiB;
constexpr size_t WS_WOUTE = 78 * MiB;
constexpr size_t WS_WINO = 110 * MiB;
constexpr size_t WS_WOUTO = 126 * MiB;
constexpr size_t WS_WPOOL = 142 * MiB;
constexpr size_t WS_W2T = 1304 * MiB;
constexpr size_t WS_WUP = 146 * MiB;
constexpr size_t WS_WDN = 322 * MiB;
constexpr size_t WS_X = 410 * MiB;
constexpr size_t WS_H = 602 * MiB;
constexpr size_t WS_PROJ = 698 * MiB;
constexpr size_t WS_G = WS_PROJ;
constexpr size_t WS_HC = WS_PROJ;
constexpr size_t WS_PL = WS_PROJ + 96 * MiB;
constexpr size_t WS_PO = WS_PROJ + 192 * MiB;
constexpr size_t WS_DT = 1130 * MiB;
constexpr size_t WS_GWSB = 2 * MiB;
constexpr size_t WS_CSN = 1136 * MiB;
constexpr size_t WS_BTG = 1160 * MiB;
constexpr size_t WS_CBP = 1184 * MiB;
constexpr size_t WS_XST = 1208 * MiB;
constexpr size_t WS_YF = 1328 * MiB;
constexpr size_t WS_YB = 1424 * MiB;
constexpr size_t WS_DELTA = WS_YF;
constexpr size_t WS_ACS = 1520 * MiB;
constexpr size_t WS_DTV = 1526 * MiB;
constexpr size_t WS_END = 1532 * MiB;
static_assert(WS_WINE + (size_t)2 * IN_PAD * D * 2 <= WS_WOUTE, "map");
static_assert(WS_WUP + (size_t)4 * NFU * D * 2 <= WS_WDN && WS_WDN + (size_t)4 * D * FF * 2 <= WS_X, "map");
static_assert(WS_X + (size_t)M * D * 4 <= WS_H && WS_H + (size_t)M * D * 2 <= WS_PROJ, "map");
static_assert(WS_PROJ + (size_t)M * PROJ_LD * 2 <= WS_DT && WS_DT + (size_t)M * 64 * 4 <= WS_CSN, "map");
static_assert(WS_CSN + (size_t)M * 512 * 2 <= WS_BTG && WS_BTG + (size_t)M * 512 * 2 <= WS_CBP && WS_CBP + (size_t)M * 512 * 2 <= WS_XST && WS_XST + (size_t)M * D * 2 <= WS_YF, "map");
static_assert(WS_YB + (size_t)M * D * 2 <= WS_ACS && WS_DTV + (size_t)M * 64 * 4 <= WS_END, "map");
constexpr int CW_TMO = 0;
constexpr int CW_BAR = 4096;

constexpr int RING_BYTES = 131072;
constexpr int LDS_BYTES = 155648;
constexpr int MISC_OFF = LDS_BYTES - 256;

#define GAS __attribute__((address_space(1)))
#define LAS __attribute__((address_space(3)))
typedef unsigned short bf16;
typedef unsigned v4u __attribute__((ext_vector_type(4)));
typedef unsigned v2u __attribute__((ext_vector_type(2)));
typedef float f32x4 __attribute__((ext_vector_type(4)));
typedef float f32x2 __attribute__((ext_vector_type(2)));
typedef short bf16x8 __attribute__((ext_vector_type(8)));
#define LDS_WAIT() asm volatile("s_waitcnt lgkmcnt(0)" ::: "memory")
#define VM_WAIT() asm volatile("s_waitcnt vmcnt(0)" ::: "memory")

__device__ __forceinline__ unsigned f2bf(float f) { unsigned u = __builtin_bit_cast(unsigned, f); return (u + 0x7fffu + ((u >> 16) & 1u)) >> 16; }
typedef __bf16 hwbf16x2 __attribute__((ext_vector_type(2)));
__device__ __forceinline__ unsigned pk2(float lo, float hi) { const f32x2 v = {lo, hi}; return __builtin_bit_cast(unsigned, __builtin_convertvector(v, hwbf16x2)); }
__device__ __forceinline__ float bf2f(unsigned b) { return __builtin_bit_cast(float, b << 16); }
__device__ __forceinline__ float bflo(unsigned w) { return __builtin_bit_cast(float, w << 16); }
__device__ __forceinline__ float bfhi(unsigned w) { return __builtin_bit_cast(float, w & 0xffff0000u); }
__device__ __forceinline__ float silu_f(float x) { return x * __builtin_amdgcn_rcpf(1.0f + __expf(-x)); }
__device__ __forceinline__ float gelu_tanh_f(float x) {
    const float y2 = -1.5957691216057308f * x * (1.0f + 0.044715f * x * x);
    return x * __builtin_amdgcn_rcpf(1.0f + __expf(y2));
}
__device__ __forceinline__ float softplus_f(float x) { return x > 20.f ? x : log1pf(__expf(x)); }
__device__ __forceinline__ float wave_sum(float v) {
#pragma unroll
    for (int o = 1; o < 64; o <<= 1) v += __shfl_xor(v, o);
    return v;
}
__device__ __forceinline__ int cond_idx(int row) { return row < MC ? 4 : ((row - MC) >> 12); }

namespace pg8 {
#define PG8_LAS __attribute__((address_space(3)))
typedef unsigned short bf16_t;
constexpr int BM = 256, BK = 64, HALF = 128, HTB = HALF * BK * 2, STAGE_BYTES = 8 * HTB, NXCD = 8, WGM = 8;
__host__ __device__ __forceinline__ int lds_byte(int r, int c) { const int st = (r >> 4) * 2 + (c >> 5), rr = r & 15, cc = c & 31, ob = rr * 64 + cc * 2; return st * 1024 + (ob ^ (((ob >> 9) & 1) << 5)); }
__host__ __device__ __forceinline__ void stage_rc(int b, int& R, int& C) { const int st = b / 1024, sb = b % 1024, swz = sb ^ (((sb >> 9) & 1) << 5); R = (st >> 1) * 16 + swz / 64; C = (st & 1) * 32 + (swz % 64) / 2; }
__host__ __device__ __forceinline__ int perm32(int rho) { const int n = rho >> 4, i = rho & 15; return 8 * (i >> 2) + 4 * n + (i & 3); }

struct Unit { int pm, pn; };
struct Gemm { const bf16_t* A; const bf16_t* Bt; int M, N, K, lda, agrp, bgrp; };

struct StaticOrder {
    int nM, nN, nwg, G, c, wgm;
    __host__ __device__ void init(int M_, int N_, int G_, int c_, int wgm_ = WGM) { nM = M_ / BM; nN = N_ / BM; nwg = nM * nN; G = G_; c = c_; wgm = wgm_; }
    __host__ __device__ bool next(int i, Unit& u) const {
        const long L = (long)i * G + c; if (L >= nwg) return false;
        int wgid = (int)L; { const int q = nwg / NXCD, r = nwg % NXCD, xcd = wgid % NXCD, off = wgid / NXCD; wgid = (xcd < r ? xcd * (q + 1) : r * (q + 1) + (xcd - r) * q) + off; }
        const int nig = wgm * nN, gid = wgid / nig, fm = gid * wgm, gsz = (nM - fm) < wgm ? (nM - fm) : wgm;
        u.pm = fm + ((wgid % nig) % gsz); u.pn = (wgid % nig) / gsz; return true;
    }
    __device__ __forceinline__ void a_ready(const Unit&) const {}
    __device__ __forceinline__ void done(const Unit&) const {}
};

__device__ __forceinline__ unsigned cvt_pk_bf16(float lo, float hi) { unsigned r; asm volatile("v_cvt_pk_bf16_f32 %0, %1, %2" : "=v"(r) : "v"(lo), "v"(hi)); return r; }


struct EpiInEven {
    static constexpr bool PERM = true, AFTER_DRAIN = false;
    bf16_t* P; float* DT;
    __device__ __forceinline__ void operator()(const f32x4 (&acc)[2][2][4][2], const Unit& u, int wr, int wc, int fr, int fq) const {
        const int row0 = u.pm * BM + wr * 64 + fr;
        if (u.pn < 36) {
            const int mode = u.pn < 16 ? 0 : (u.pn < 24 ? 1 : 2);
            const int col0 = u.pn * BM + wc * 32 + 8 * fq;
#pragma unroll
            for (int ai = 0; ai < 2; ++ai)
#pragma unroll
                for (int m = 0; m < 4; ++m) { bf16_t* rowp = P + (size_t)(row0 + ai * HALF + m * 16) * PROJ_LD + col0;
#pragma unroll
                    for (int bj = 0; bj < 2; ++bj) { f32x4 v0 = acc[ai][bj][m][0], v1 = acc[ai][bj][m][1];
                        if (mode == 0) {
#pragma unroll
                            for (int j = 0; j < 4; ++j) { v0[j] = gelu_tanh_f(v0[j]); v1[j] = gelu_tanh_f(v1[j]); } }
                        else if (mode == 1) {
#pragma unroll
                            for (int j = 0; j < 4; ++j) { v0[j] = silu_f(v0[j]); v1[j] = silu_f(v1[j]); } }
                        v4u w; w.x = cvt_pk_bf16(v0[0], v0[1]); w.y = cvt_pk_bf16(v0[2], v0[3]); w.z = cvt_pk_bf16(v1[0], v1[1]); w.w = cvt_pk_bf16(v1[2], v1[3]);
                        *(v4u*)(rowp + bj * HALF) = w; } }
        } else if (wc < 2) {
#pragma unroll
            for (int ai = 0; ai < 2; ++ai)
#pragma unroll
                for (int m = 0; m < 4; ++m) { float* rp = DT + (size_t)(row0 + ai * HALF + m * 16) * 64 + wc * 32 + 8 * fq;
                    *(f32x4*)rp = acc[ai][0][m][0]; *(f32x4*)(rp + 4) = acc[ai][0][m][1]; }
        }
    }
};
struct EpiBf16 {
    static constexpr bool PERM = true, AFTER_DRAIN = false;
    bf16_t* O; int ldc; const float* scale;
    __device__ __forceinline__ void operator()(const f32x4 (&acc)[2][2][4][2], const Unit& u, int wr, int wc, int fr, int fq) const {
        const int row0 = u.pm * BM + wr * 64 + fr, col0 = u.pn * BM + wc * 32 + 8 * fq;
        f32x4 sv[2][2];
#pragma unroll
        for (int bj = 0; bj < 2; ++bj)
#pragma unroll
            for (int n = 0; n < 2; ++n) sv[bj][n] = scale ? *(const f32x4*)(scale + col0 + bj * HALF + 4 * n) : (f32x4){1.f, 1.f, 1.f, 1.f};
#pragma unroll
        for (int ai = 0; ai < 2; ++ai)
#pragma unroll
            for (int m = 0; m < 4; ++m) { bf16_t* rowp = O + (size_t)(row0 + ai * HALF + m * 16) * ldc + col0;
#pragma unroll
                for (int bj = 0; bj < 2; ++bj) { const f32x4 v0 = acc[ai][bj][m][0] * sv[bj][0], v1 = acc[ai][bj][m][1] * sv[bj][1];
                    v4u w; w.x = cvt_pk_bf16(v0[0], v0[1]); w.y = cvt_pk_bf16(v0[2], v0[3]); w.z = cvt_pk_bf16(v1[0], v1[1]); w.w = cvt_pk_bf16(v1[2], v1[3]);
                    *(v4u*)(rowp + bj * HALF) = w; } }
    }
};
struct EpiRes {
    static constexpr bool PERM = false, AFTER_DRAIN = false;
    const float* base_c; const float* base_s; float* X; const float* gate;
    __device__ __forceinline__ void operator()(const f32x4 (&acc)[2][2][4][2], const Unit& u, int wr, int wc, int fr, int fq) const {
        const int rowt = u.pm * BM, row0 = rowt + wr * 64 + fr, col0 = u.pn * BM + wc * 32 + 4 * fq;
        const float* g = gate + (size_t)cond_idx(rowt) * NMOD + col0;
        const float* bp = rowt < MC ? base_c + (size_t)row0 * D : base_s + (size_t)(row0 - MC) * D;
        f32x4 gv[2][2];
#pragma unroll
        for (int bj = 0; bj < 2; ++bj)
#pragma unroll
            for (int n = 0; n < 2; ++n) gv[bj][n] = *(const f32x4*)(g + bj * HALF + n * 16);
#pragma unroll
        for (int ai = 0; ai < 2; ++ai) {
            f32x4 bb[4][2][2];
#pragma unroll
            for (int m = 0; m < 4; ++m)
#pragma unroll
                for (int bj = 0; bj < 2; ++bj)
#pragma unroll
                    for (int n = 0; n < 2; ++n) bb[m][bj][n] = *(const f32x4*)(bp + (size_t)(ai * HALF + m * 16) * D + col0 + bj * HALF + n * 16);
#pragma unroll
            for (int m = 0; m < 4; ++m) { float* xo = X + (size_t)(row0 + ai * HALF + m * 16) * D + col0;
#pragma unroll
                for (int bj = 0; bj < 2; ++bj)
#pragma unroll
                    for (int n = 0; n < 2; ++n) *(f32x4*)(xo + bj * HALF + n * 16) = bb[m][bj][n] + gv[bj][n] * acc[ai][bj][m][n]; }
            asm volatile("" ::: "memory"); }
    }
};
struct EpiDelta {
    static constexpr bool PERM = true, AFTER_DRAIN = false;
    bf16_t* O; const float* gate;
    __device__ __forceinline__ void operator()(const f32x4 (&acc)[2][2][4][2], const Unit& u, int wr, int wc, int fr, int fq) const {
        const int rowt = u.pm * BM, row0 = rowt + wr * 64 + fr, col0 = u.pn * BM + wc * 32 + 8 * fq;
        const float* g = gate + (size_t)cond_idx(rowt) * NMOD + col0;
        f32x4 sv[2][2];
#pragma unroll
        for (int bj = 0; bj < 2; ++bj)
#pragma unroll
            for (int n = 0; n < 2; ++n) sv[bj][n] = *(const f32x4*)(g + bj * HALF + 4 * n);
#pragma unroll
        for (int ai = 0; ai < 2; ++ai)
#pragma unroll
            for (int m = 0; m < 4; ++m) { bf16_t* rowp = O + (size_t)(row0 + ai * HALF + m * 16) * D + col0;
#pragma unroll
                for (int bj = 0; bj < 2; ++bj) { const f32x4 v0 = acc[ai][bj][m][0] * sv[bj][0], v1 = acc[ai][bj][m][1] * sv[bj][1];
                    v4u w; w.x = cvt_pk_bf16(v0[0], v0[1]); w.y = cvt_pk_bf16(v0[2], v0[3]); w.z = cvt_pk_bf16(v1[0], v1[1]); w.w = cvt_pk_bf16(v1[2], v1[3]);
                    *(v4u*)(rowp + bj * HALF) = w; } }
    }
};
struct EpiFfnUp {
    static constexpr bool PERM = true, AFTER_DRAIN = false;
    bf16_t* G;
    __device__ __forceinline__ void operator()(const f32x4 (&acc)[2][2][4][2], const Unit& u, int wr, int wc, int fr, int fq) const {
        const int row0 = u.pm * BM + wr * 64 + fr, col0 = u.pn * HALF + wc * 32 + 8 * fq;
#pragma unroll
        for (int ai = 0; ai < 2; ++ai)
#pragma unroll
            for (int m = 0; m < 4; ++m) { bf16_t* rowp = G + (size_t)(row0 + ai * HALF + m * 16) * FF + col0;
                f32x4 v0, v1;
#pragma unroll
                for (int j = 0; j < 4; ++j) { v0[j] = silu_f(acc[ai][0][m][0][j]) * acc[ai][1][m][0][j]; v1[j] = silu_f(acc[ai][0][m][1][j]) * acc[ai][1][m][1][j]; }
                v4u w; w.x = cvt_pk_bf16(v0[0], v0[1]); w.y = cvt_pk_bf16(v0[2], v0[3]); w.z = cvt_pk_bf16(v1[0], v1[1]); w.w = cvt_pk_bf16(v1[2], v1[3]);
                *(v4u*)rowp = w; }
    }
};

template <class Epi, class Sched, bool ALIGN_EPI = false, bool SP2 = false>
__device__ __forceinline__ void gemm_phase(PG8_LAS unsigned char* lds, const Gemm g, const Sched& S, const Epi& E) {
    int tid = threadIdx.x; asm volatile("" : "+v"(tid));
    const int wid = __builtin_amdgcn_readfirstlane(tid >> 6), lane = tid & 63, wr = wid >> 2, wc = wid & 3, fr = lane & 15, fq = lane >> 4;
    const int K = g.K, nt = K / BK, lda = g.lda;
    unsigned voffA[2], voffB[2];
#pragma unroll
    for (int i = 0; i < 2; ++i) { int R, C; stage_rc(tid * 16 + i * 8192, R, C); const int Rb = Epi::PERM ? ((R & ~31) + perm32(R & 31)) : R;
        voffA[i] = (unsigned)(R * lda + C) * 2u; voffB[i] = (unsigned)(Rb * K + C) * 2u; }
    const size_t kstep = (size_t)(BK * 2);
    const size_t hstepA = (size_t)HALF * lda * 2, hstepB = (size_t)HALF * K * 2;
    const size_t tstepA = 2 * hstepA, tstepB = 2 * hstepB;
    const unsigned ldsw = (unsigned)wid * 1024u;
    const int aoff = lds_byte(wr * 64 + fr, fq * 8), boff = lds_byte(wc * 32 + fr, fq * 8);
#define PG8_SA(b, h) (((b) * 2 + (h)) * HTB)
#define PG8_SB(b, h) ((4 + (b) * 2 + (h)) * HTB)
#define PG8_STAGE(bufoff, gbase, voff) do { _Pragma("unroll") for (int _i = 0; _i < 2; ++_i) \
        __builtin_amdgcn_global_load_lds((const unsigned*)((const char*)(gbase) + (voff)[_i]), (PG8_LAS unsigned*)(lds + (bufoff) + ldsw + _i * 8192), 16, 0, 0); } while (0)
#define PG8_LDA(dst, b, h) do { _Pragma("unroll") for (int m = 0; m < 4; ++m) _Pragma("unroll") for (int k = 0; k < 2; ++k) dst[m][k] = *(const PG8_LAS bf16x8*)(lds + PG8_SA(b, h) + aoff + m * 2048 + k * 1024); } while (0)
#define PG8_LDB(dst, b, h) do { _Pragma("unroll") for (int n = 0; n < 2; ++n) _Pragma("unroll") for (int k = 0; k < 2; ++k) dst[n][k] = *(const PG8_LAS bf16x8*)(lds + PG8_SB(b, h) + boff + n * 2048 + k * 1024); } while (0)
#define PG8_MMA(ai, bj, At, Bt) do { __builtin_amdgcn_s_setprio(1); _Pragma("unroll") for (int m = 0; m < 4; ++m) _Pragma("unroll") for (int n = 0; n < 2; ++n) _Pragma("unroll") for (int k = 0; k < 2; ++k) \
        acc[ai][bj][m][n] = __builtin_amdgcn_mfma_f32_16x16x32_bf16(Bt[n][k], At[m][k], acc[ai][bj][m][n], 0, 0, 0); __builtin_amdgcn_s_setprio(0); } while (0)
#define PG8_WAIT_V(n) asm volatile("s_waitcnt vmcnt(" #n ")" ::: "memory")
#define PG8_WAIT_L(n) asm volatile("s_waitcnt lgkmcnt(" #n ")" ::: "memory")
#define PG8_BAR __builtin_amdgcn_s_barrier()
#define PG8_SCHED __builtin_amdgcn_sched_barrier(0)
#define PG8_ABASE(u) ((const char*)g.A + (size_t)(u).pm * tstepA + (g.agrp ? (size_t)((u).pn / g.agrp) * (size_t)K * 2 : (size_t)0))
#define PG8_BBASE(u) ((const char*)g.Bt + (size_t)((g.bgrp ? ((u).pm / g.bgrp) * (g.N / BM) : 0) + (u).pn) * tstepB)
    Unit cur, nxt; int ui = 0;
    if (!S.next(0, cur)) return;
    f32x4 acc[2][2][4][2];
#pragma unroll
    for (int a = 0; a < 2; ++a)
#pragma unroll
        for (int b = 0; b < 2; ++b)
#pragma unroll
            for (int m = 0; m < 4; ++m)
#pragma unroll
                for (int n = 0; n < 2; ++n) acc[a][b][m][n] = (f32x4){0.f, 0.f, 0.f, 0.f};
    bf16x8 At[4][2], B0[2][2], B1[2][2];
    const char* cA = PG8_ABASE(cur); const char* cB = PG8_BBASE(cur);
    S.a_ready(cur);
    if constexpr (SP2) {
        PG8_STAGE(PG8_SB(0, 0), cB, voffB); PG8_STAGE(PG8_SB(0, 1), cB + hstepB, voffB); PG8_STAGE(PG8_SA(0, 0), cA, voffA); PG8_STAGE(PG8_SA(0, 1), cA + hstepA, voffA);
        if (wr == 1) PG8_BAR;
        PG8_WAIT_V(2); PG8_BAR;
        PG8_STAGE(PG8_SB(1, 0), cB + kstep, voffB); PG8_STAGE(PG8_SA(1, 0), cA + kstep, voffA); PG8_STAGE(PG8_SB(1, 1), cB + hstepB + kstep, voffB);
        PG8_WAIT_V(6); PG8_BAR;
    } else {
        PG8_STAGE(PG8_SB(0, 0), cB, voffB); PG8_STAGE(PG8_SA(0, 0), cA, voffA); PG8_STAGE(PG8_SB(0, 1), cB + hstepB, voffB); PG8_STAGE(PG8_SA(0, 1), cA + hstepA, voffA);
        if (wr == 1) PG8_BAR;
        PG8_WAIT_V(4); PG8_BAR;
        PG8_STAGE(PG8_SB(1, 0), cB + kstep, voffB); PG8_STAGE(PG8_SA(1, 0), cA + kstep, voffA); PG8_STAGE(PG8_SB(1, 1), cB + hstepB + kstep, voffB);
        PG8_WAIT_V(6); PG8_BAR;
    }
    for (;;) {
        const bool has_next = S.next(ui + 1, nxt);
        const char* nA = has_next ? PG8_ABASE(nxt) : cA; const char* nB = has_next ? PG8_BBASE(nxt) : cB;
        for (int t = 0; t < nt; t += 2) {
            const bool last = (t == nt - 2);
            const char* a1 = cA + (size_t)(t + 1) * kstep;
            const char* a2 = last ? nA : cA + (size_t)(t + 2) * kstep; const char* b2 = last ? nB : cB + (size_t)(t + 2) * kstep;
            const char* a3 = a2 + kstep; const char* b3 = b2 + kstep;
            if (last && has_next) S.a_ready(nxt);
            if constexpr (SP2) {
            PG8_LDB(B0, 0, 0); PG8_LDB(B1, 0, 1); PG8_SCHED; PG8_LDA(At, 0, 0); PG8_STAGE(PG8_SA(1, 1), a1 + hstepA, voffA);
            PG8_WAIT_V(8); PG8_WAIT_L(0); PG8_BAR; PG8_MMA(0, 0, At, B0); PG8_MMA(0, 1, At, B1); PG8_BAR; PG8_SCHED;
            PG8_LDA(At, 0, 1); PG8_STAGE(PG8_SB(0, 0), b2, voffB); PG8_STAGE(PG8_SB(0, 1), b2 + hstepB, voffB); PG8_STAGE(PG8_SA(0, 0), a2, voffA);
            PG8_WAIT_V(8); PG8_WAIT_L(0); PG8_BAR; PG8_MMA(1, 0, At, B0); PG8_MMA(1, 1, At, B1); PG8_BAR; PG8_SCHED;
            PG8_LDB(B0, 1, 0); PG8_LDB(B1, 1, 1); PG8_SCHED; PG8_LDA(At, 1, 0); PG8_STAGE(PG8_SA(0, 1), a2 + hstepA, voffA);
            PG8_WAIT_V(8); PG8_WAIT_L(0); PG8_BAR; PG8_MMA(0, 0, At, B0); PG8_MMA(0, 1, At, B1); PG8_BAR; PG8_SCHED;
            PG8_LDA(At, 1, 1); PG8_STAGE(PG8_SB(1, 0), b3, voffB); PG8_STAGE(PG8_SB(1, 1), b3 + hstepB, voffB); PG8_STAGE(PG8_SA(1, 0), a3, voffA);
            PG8_WAIT_V(8); PG8_WAIT_L(0); PG8_BAR; PG8_MMA(1, 0, At, B0); PG8_MMA(1, 1, At, B1); PG8_BAR; PG8_SCHED;
            } else {
            PG8_LDB(B0, 0, 0); PG8_SCHED; PG8_LDA(At, 0, 0); PG8_STAGE(PG8_SA(1, 1), a1 + hstepA, voffA);
            PG8_WAIT_L(8); PG8_BAR; PG8_WAIT_L(0); PG8_MMA(0, 0, At, B0); PG8_BAR; PG8_SCHED;
            PG8_LDB(B1, 0, 1); PG8_STAGE(PG8_SB(0, 0), b2, voffB);
            PG8_BAR; PG8_WAIT_L(0); PG8_MMA(0, 1, At, B1); PG8_BAR;
            PG8_LDA(At, 0, 1); PG8_STAGE(PG8_SA(0, 0), a2, voffA);
            PG8_BAR; PG8_WAIT_L(0); PG8_MMA(1, 0, At, B0); PG8_BAR; PG8_SCHED;
            PG8_STAGE(PG8_SB(0, 1), b2 + hstepB, voffB);
            PG8_WAIT_V(6); PG8_BAR; PG8_MMA(1, 1, At, B1); PG8_BAR;
            PG8_LDB(B0, 1, 0); PG8_SCHED; PG8_LDA(At, 1, 0); PG8_STAGE(PG8_SA(0, 1), a2 + hstepA, voffA);
            PG8_WAIT_L(8); PG8_BAR; PG8_WAIT_L(0); PG8_MMA(0, 0, At, B0); PG8_BAR; PG8_SCHED;
            PG8_LDB(B1, 1, 1); PG8_STAGE(PG8_SB(1, 0), b3, voffB);
            PG8_BAR; PG8_WAIT_L(0); PG8_MMA(0, 1, At, B1); PG8_BAR;
            PG8_LDA(At, 1, 1); PG8_STAGE(PG8_SA(1, 0), a3, voffA);
            PG8_BAR; PG8_WAIT_L(0); PG8_MMA(1, 0, At, B0); PG8_BAR; PG8_SCHED;
            PG8_STAGE(PG8_SB(1, 1), b3 + hstepB, voffB);
            PG8_WAIT_V(6); PG8_BAR; PG8_MMA(1, 1, At, B1); PG8_BAR;
            }
        }
        if constexpr (ALIGN_EPI) { if (wr == 0) PG8_BAR; }
        if constexpr (!Epi::AFTER_DRAIN) { E(acc, cur, wr, wc, fr, fq); S.done(cur); }
        if (!has_next) break;
#pragma unroll
        for (int a = 0; a < 2; ++a)
#pragma unroll
            for (int b = 0; b < 2; ++b)
#pragma unroll
                for (int m = 0; m < 4; ++m)
#pragma unroll
                    for (int n = 0; n < 2; ++n) acc[a][b][m][n] = (f32x4){0.f, 0.f, 0.f, 0.f};
        cur = nxt; cA = nA; cB = nB; ++ui;
        if constexpr (ALIGN_EPI) { if (wr == 1) PG8_BAR; }
    }
    PG8_WAIT_V(0);
    if constexpr (!ALIGN_EPI) { if (wr == 0) PG8_BAR; }
    PG8_BAR;
#undef PG8_SA
#undef PG8_SB
#undef PG8_STAGE
#undef PG8_LDA
#undef PG8_LDB
#undef PG8_MMA
#undef PG8_WAIT_V
#undef PG8_WAIT_L
#undef PG8_BAR
#undef PG8_SCHED
#undef PG8_ABASE
#undef PG8_BBASE
}
}

#define XB_TMO      128
#define XB_XCNT(j)  (256  + 64 * (j))
#define XB_XSUB(j)  (1280 + 64 * (j))
#define XB_XGEN(j)  (2304 + 64 * (j))
#define XB_TOP      3328
#define XB_TOPGEN   3392
#define XCD_BAR_WORDS 3456
#define XB_SPIN_CAP (1u << 18)
__device__ __forceinline__ unsigned xb_ld(unsigned* p)              { return __hip_atomic_load(p, __ATOMIC_RELAXED, __HIP_MEMORY_SCOPE_AGENT); }
__device__ __forceinline__ unsigned xb_add(unsigned* p, unsigned v) { return __hip_atomic_fetch_add(p, v, __ATOMIC_RELAXED, __HIP_MEMORY_SCOPE_AGENT); }
__device__ __forceinline__ unsigned xb_xcc_id() { return (unsigned)__builtin_amdgcn_s_getreg((3 << 11) | 20) & 0xFu; }
#define XB_SPIN(cond, bar) do { unsigned _sp = 0; while (cond) { __builtin_amdgcn_s_sleep(1); \
    if ((++_sp & 255u) == 0u) { if (xb_ld(&(bar)[XB_TMO])) break; if (_sp > XB_SPIN_CAP) { atomicAdd(&(bar)[XB_TMO], 1u); break; } } } } while (0)
struct XcdBarrier { unsigned* bar; unsigned x; volatile LAS unsigned* st; };
__device__ __forceinline__ XcdBarrier xcd_barrier_post(unsigned* bar, volatile LAS unsigned* st) {
    XcdBarrier b; b.bar = bar; b.x = xb_xcc_id(); b.st = st;
    if (threadIdx.x == 0) (void)xb_add(&bar[XB_XCNT(b.x)], 1u);
    return b;
}
__device__ __forceinline__ void xcd_barrier_complete(unsigned* bar, unsigned x, unsigned& nloc, unsigned& nx) {
    const unsigned G = gridDim.x * gridDim.y * gridDim.z;
    unsigned sum, cnt, mine, sp = 0u;
    for (;;) {
        sum = 0u; cnt = 0u; mine = 0u;
#pragma unroll
        for (unsigned j = 0; j < 16; ++j) { const unsigned c = xb_ld(&bar[XB_XCNT(j)]); sum += c; cnt += (c > 0u) ? 1u : 0u; mine = (j == x) ? c : mine; }
        if (sum == G) break;
        __builtin_amdgcn_s_sleep(1);
        if ((++sp & 255u) == 0u) { if (xb_ld(&bar[XB_TMO])) break; if (sp > XB_SPIN_CAP) { atomicAdd(&bar[XB_TMO], 1u); break; } }
    }
    nloc = mine > 0u ? mine : 1u; nx = cnt > 0u ? cnt : 1u;
}
__device__ __forceinline__ void xcd_barrier(const XcdBarrier& b) {
    asm volatile("s_waitcnt vmcnt(0)" ::: "memory");
    __syncthreads();
    if (threadIdx.x == 0) {
        unsigned* bar = b.bar;
        __builtin_amdgcn_s_waitcnt(0);
        unsigned nloc = b.st[0], nx = b.st[1];
        if (nloc == 0u) { xcd_barrier_complete(bar, b.x, nloc, nx); b.st[0] = nloc; b.st[1] = nx; }
        const unsigned old = xb_add(&bar[XB_XSUB(b.x)], 1u);
        const unsigned gen = old / nloc;
        if (old + 1u == (gen + 1u) * nloc) {
            __builtin_amdgcn_fence(__ATOMIC_RELEASE, "agent");
            asm volatile("s_waitcnt vmcnt(0)" ::: "memory");
            const unsigned og = xb_add(&bar[XB_TOP], 1u);
            const unsigned tg = og / nx;
            if (og + 1u == (tg + 1u) * nx) xb_add(&bar[XB_TOPGEN], 1u);
            else XB_SPIN(xb_ld(&bar[XB_TOPGEN]) == tg, bar);
            __builtin_amdgcn_fence(__ATOMIC_ACQUIRE, "agent");
            xb_add(&bar[XB_XGEN(b.x)], 1u);
            asm volatile("s_waitcnt vmcnt(0)" ::: "memory");
        } else {
            XB_SPIN(xb_ld(&bar[XB_XGEN(b.x)]) == gen, bar);
            __builtin_amdgcn_fence(__ATOMIC_ACQUIRE, "agent");
            asm volatile("s_waitcnt vmcnt(0)" ::: "memory");
        }
    }
    __syncthreads();
}

struct Args {
    const float* in[28]; float* out; unsigned char* ws; int ph_lo, ph_hi, li, pad;
};
enum { I_XP = 0, I_XS, I_STATE, I_C, I_CCTX, I_WMOD, I_BMOD, I_NMIX, I_NFFN, I_WINE, I_WOUTE, I_GNORM, I_GWS, I_GBS, I_CONVW, I_CONVB,
       I_DTB, I_ALOG, I_SSDD, I_SNORM, I_WINO, I_POOLW, I_PSCALE, I_WOUTO, I_W1, I_W3, I_W2, I_FNORM };

typedef __attribute__((address_space(4))) const Args CArgs;
__device__ __forceinline__ CArgs* kargs(int salt) { CArgs* p = (CArgs*)__builtin_amdgcn_kernarg_segment_ptr(); asm volatile("" : "+s"(p) : "s"(salt)); return p; }

struct TItem { const float* src; bf16* dst; int ldw, K; };
__device__ __forceinline__ void titem_load(const TItem& t, int lane, f32x4 (&v)[16]) {
    const int lr = lane >> 4, lc = 4 * (lane & 15);
#pragma unroll
    for (int i = 0; i < 16; ++i) v[i] = *(const f32x4*)(t.src + (size_t)(4 * i + lr) * t.ldw + lc);
}
__device__ __forceinline__ void titem_store(const TItem& t, int lane, const f32x4 (&v)[16], LAS float* scr) {
    constexpr int PT = 65;
    const int lr = lane >> 4, lc = 4 * (lane & 15);
#pragma unroll
    for (int i = 0; i < 16; ++i) { LAS float* sp = scr + (4 * i + lr) * PT + lc; sp[0] = v[i][0]; sp[1] = v[i][1]; sp[2] = v[i][2]; sp[3] = v[i][3]; }
    LDS_WAIT(); asm volatile("" ::: "memory");
    const int c = lane & 7;
#pragma unroll
    for (int j = 0; j < 8; ++j) { const int n = (lane >> 3) + 8 * j; const LAS float* sp = scr + (8 * c) * PT + n;
        v4u o; o.x = pk2(sp[0 * PT], sp[1 * PT]); o.y = pk2(sp[2 * PT], sp[3 * PT]); o.z = pk2(sp[4 * PT], sp[5 * PT]); o.w = pk2(sp[6 * PT], sp[7 * PT]);
        *(v4u*)(t.dst + (size_t)n * t.K + 8 * c) = o; }
    LDS_WAIT(); asm volatile("" ::: "memory");
}

struct Frame {
    LAS unsigned char* lds;
    volatile LAS unsigned* MISC;
    unsigned* ctl;
    int tid, lane, wave, G, bid;
    float* out; unsigned char* ws;
};

__device__ __forceinline__ Frame mkframe(CArgs* A) {
    extern __shared__ __attribute__((aligned(16))) unsigned char lds_base[];
    Frame F; int t = threadIdx.x; asm volatile("" : "+v"(t));
    F.lds = (LAS unsigned char*)lds_base; F.MISC = (volatile LAS unsigned*)(F.lds + MISC_OFF);
    F.tid = t; F.lane = t & 63; F.wave = __builtin_amdgcn_readfirstlane(t >> 6);
    int g = gridDim.x, b = blockIdx.x; asm volatile("" : "+s"(g), "+s"(b));
    F.G = g; F.bid = b; F.out = A->out; F.ws = A->ws; F.ctl = (unsigned*)(A->ws + WS_CTL);
    return F;
}
__device__ __forceinline__ TItem titem_up(CArgs& args, unsigned char* ws, int l, int r) {
    const int w3 = r / (32 * 88), q = r % (32 * 88), kb = q / 88, nb = q % 88, n0 = 64 * nb; TItem t;
    t.src = (w3 ? args.in[I_W3] : args.in[I_W1]) + (size_t)l * D * FF + (size_t)(64 * kb) * FF + n0; t.ldw = FF; t.K = D;
    t.dst = (bf16*)(ws + WS_WUP) + (size_t)l * NFU * D + (size_t)(256 * (n0 >> 7) + (n0 & 127) + (w3 ? 128 : 0)) * D + 64 * kb; return t;
}
__device__ __forceinline__ TItem titem_down(CArgs& args, unsigned char* ws, int l, int r) {
    const int kb = r / 32, nb = r % 32; TItem t;
    t.src = args.in[I_W2] + (size_t)l * FF * D + (size_t)(64 * kb) * D + 64 * nb; t.ldw = D; t.K = FF; t.dst = (bf16*)(ws + WS_WDN) + (size_t)l * D * FF + (size_t)(64 * nb) * FF + 64 * kb; return t;
}
constexpr int TI_UP = 2 * 32 * 88, TI_DN = 88 * 32;
__device__ __forceinline__ int titem_count(int set) {
    constexpr int I_INE = 2 * 32 * 145, I_OUTE = 2 * 64 * 32, I_INO = 2 * 32 * 32, I_OUTO = 2 * 32 * 32;
    return set == 0 ? I_INE + I_OUTE + I_INO + I_OUTO + TI_UP : (set == DEPTH ? TI_DN : TI_DN + TI_UP);
}
__device__ __forceinline__ TItem titem_decode(CArgs& args, unsigned char* ws, int set, int it) {
    constexpr int I_INE = 2 * 32 * 145, I_OUTE = 2 * 64 * 32, I_INO = 2 * 32 * 32, I_OUTO = 2 * 32 * 32;
    if (set > 0) { const int l = set - 1; return it < TI_DN ? titem_down(args, ws, l, it) : titem_up(args, ws, l + 1, it - TI_DN); }
    TItem t; int r = it;
    if (r < I_INE) { const int e = r / (32 * 145), q = r % (32 * 145), kb = q / 145, nb = q % 145;
        t.src = args.in[I_WINE] + (size_t)e * D * IN_EVEN + (size_t)(64 * kb) * IN_EVEN + 64 * nb; t.ldw = IN_EVEN; t.K = D; t.dst = (bf16*)(ws + WS_WINE) + (size_t)e * IN_PAD * D + (size_t)(64 * nb) * D + 64 * kb; return t; }
    r -= I_INE;
    if (r < I_OUTE) { const int e = r / (64 * 32), q = r % (64 * 32), kb = q / 32, nb = q % 32;
        t.src = args.in[I_WOUTE] + (size_t)e * 4096 * D + (size_t)(64 * kb) * D + 64 * nb; t.ldw = D; t.K = 4096; t.dst = (bf16*)(ws + WS_WOUTE) + (size_t)e * D * 4096 + (size_t)(64 * nb) * 4096 + 64 * kb; return t; }
    r -= I_OUTE;
    if (r < I_INO) { const int o = r / 1024, q = r % 1024, kb = q / 32, nb = q % 32;
        t.src = args.in[I_WINO] + (size_t)o * D * D + (size_t)(64 * kb) * D + 64 * nb; t.ldw = D; t.K = D; t.dst = (bf16*)(ws + WS_WINO) + (size_t)o * D * D + (size_t)(64 * nb) * D + 64 * kb; return t; }
    r -= I_INO;
    if (r < I_OUTO) { const int o = r / 1024, q = r % 1024, kb = q / 32, nb = q % 32;
        t.src = args.in[I_WOUTO] + (size_t)o * D * D + (size_t)(64 * kb) * D + 64 * nb; t.ldw = D; t.K = D; t.dst = (bf16*)(ws + WS_WOUTO) + (size_t)o * D * D + (size_t)(64 * nb) * D + 64 * kb; return t; }
    r -= I_OUTO;
    return titem_up(args, ws, 0, r);
}
__device__ __forceinline__ void convert_items(Frame& F, CArgs& args, int set, int gw, int NGW) {
    LAS float* scr = (LAS float*)(F.lds + F.wave * 16896);
    const int n = titem_count(set);
    int it = gw;
    if (it < n) {
        TItem t = titem_decode(args, F.ws, set, it); f32x4 v[16], nv[16];
        titem_load(t, F.lane, v);
        for (; it < n; it += NGW) {
            const int itn = it + NGW; TItem tn = t;
            if (itn < n) { tn = titem_decode(args, F.ws, set, itn); titem_load(tn, F.lane, nv); }
            titem_store(t, F.lane, v, scr);
            t = tn;
#pragma unroll
            for (int i = 0; i < 16; ++i) v[i] = nv[i];
        }
    }
}
__device__ __forceinline__ void p0_prologue(Frame& F, CArgs& args) {
    {
        LAS float* sc = (LAS float*)F.lds;
        LAS float* red = (LAS float*)(F.lds + 5 * D * 4);
        for (int i = F.tid; i < 5 * D; i += NTHR) { const int r = i / D, k = i % D; const float c = r < 4 ? args.in[I_C][r * D + k] : args.in[I_CCTX][k]; sc[i] = silu_f(c); }
        __syncthreads();
        float* MOD = (float*)(F.ws + WS_MOD);
        for (int u2 = F.bid; u2 < 2 * 4 * 96; u2 += F.G) {
            const int kh = u2 & 1, u = u2 >> 1, l = u / 96, j0 = (u % 96) * 128 + 2 * F.lane, kbase = kh * 1024 + F.wave * 128;
            const float* w = args.in[I_WMOD] + ((size_t)l * D + (size_t)kbase) * NMOD + j0;
            float a[5][2];
#pragma unroll
            for (int r = 0; r < 5; ++r) { a[r][0] = 0.f; a[r][1] = 0.f; }
#pragma unroll 16
            for (int k = 0; k < 128; ++k) { const f32x2 wv = *(const f32x2*)(w + (size_t)k * NMOD);
#pragma unroll
                for (int r = 0; r < 5; ++r) { const float sv = sc[r * D + kbase + k]; a[r][0] += sv * wv.x; a[r][1] += sv * wv.y; } }
#pragma unroll
            for (int r = 0; r < 5; ++r) { red[(F.wave * 5 + r) * 128 + 2 * F.lane] = a[r][0]; red[(F.wave * 5 + r) * 128 + 2 * F.lane + 1] = a[r][1]; }
            __syncthreads();
            for (int i = F.tid; i < 5 * 128; i += NTHR) { const int r = i >> 7, j = i & 127; float sum = kh ? 0.f : args.in[I_BMOD][l * NMOD + (u % 96) * 128 + j];
#pragma unroll
                for (int w8 = 0; w8 < 8; ++w8) sum += red[(w8 * 5 + r) * 128 + j];
                atomicAdd(MOD + ((size_t)l * 5 + r) * NMOD + (u % 96) * 128 + j, sum); }
            __syncthreads();
        }
    }
    __syncthreads();
    { bf16* dst = (bf16*)(F.ws + WS_WPOOL); const float* src = args.in[I_POOLW]; const float* sc2 = args.in[I_PSCALE];
      for (int i = F.bid * NTHR + F.tid; i < 2 * 2048 * 512 / 4; i += F.G * NTHR) { const int e4 = i * 4, o = e4 >> 20, gc = (e4 >> 9) & 2047, d = e4 & 511;
          const f32x4 v = *(const f32x4*)(src + e4), q = *(const f32x4*)(sc2 + o * D + (gc >> 9) * 512 + d);
          v2u w; w.x = pk2(v.x * q.x, v.y * q.y); w.y = pk2(v.z * q.z, v.w * q.w); *(v2u*)(dst + e4) = w; } }
    { bf16* dst = (bf16*)(F.ws + WS_GWSB); const float* src = args.in[I_GWS];
      for (int i = F.bid * NTHR + F.tid; i < 2 * 8 * 128 * 128; i += F.G * NTHR) dst[i] = (bf16)f2bf(src[i]); }
    convert_items(F, args, 0, F.bid * NWAVES + F.wave, F.G * NWAVES);
}

__device__ __forceinline__ void unpack8(const v4u p, float (&f)[8]) {
    f[0] = bflo(p.x); f[1] = bfhi(p.x); f[2] = bflo(p.y); f[3] = bfhi(p.y); f[4] = bflo(p.z); f[5] = bfhi(p.z); f[6] = bflo(p.w); f[7] = bfhi(p.w); }
template <bool XF32>
__device__ __forceinline__ void norm_phase(Frame& F, const float* xc, const float* xs, const bf16* XB, const bf16* DL, bf16* Xout, const float* w, const float* modl, int shc, bf16* H) {
    const int gw = F.bid * NWAVES + F.wave, NGW = F.G * NWAVES;
    f32x4 fv[8], nfv[8]; v4u xv[4], nxv[4], dv[4], ndv[4];
    float wq[4][8], sq[4][8]; int ccur = -1;
#define NORM_LOAD(row_, ff, xx, dd) do { const float* xr_ = (row_) < MC ? xc + (size_t)(row_) * D : xs + (size_t)((row_) - MC) * D; \
        _Pragma("unroll") for (int j = 0; j < 4; ++j) { const int c_ = 8 * F.lane + 512 * j; \
            if (XF32) { ff[2 * j] = *(const f32x4*)(xr_ + c_); ff[2 * j + 1] = *(const f32x4*)(xr_ + c_ + 4); } else xx[j] = *(const v4u*)(XB + (size_t)(row_) * D + c_); \
            dd[j] = DL ? *(const v4u*)(DL + (size_t)(row_) * D + c_) : (v4u){0u, 0u, 0u, 0u}; } } while (0)
    int row = gw;
    if (row < M) NORM_LOAD(row, fv, xv, dv);
    for (; row < M; row += NGW) {
        const int nrow = row + NGW;
        if (nrow < M) NORM_LOAD(nrow, nfv, nxv, ndv);
        const int ci = cond_idx(row);
        if (ci != ccur) { ccur = ci; const float* mr = modl + (size_t)ci * NMOD + shc * D;
#pragma unroll
            for (int j = 0; j < 4; ++j)
#pragma unroll
                for (int h = 0; h < 2; ++h) { const int c = 8 * F.lane + 512 * j + 4 * h; const f32x4 wv = *(const f32x4*)(w + c), sh = *(const f32x4*)(mr + c), sc = *(const f32x4*)(mr + D + c);
#pragma unroll
                    for (int q = 0; q < 4; ++q) { wq[j][4 * h + q] = wv[q] * (sc[q] + 1.0f); sq[j][4 * h + q] = sh[q]; } } }
        float x[4][8]; float s = 0.f;
#pragma unroll
        for (int j = 0; j < 4; ++j) { float d[8]; unpack8(dv[j], d);
            if (XF32) {
#pragma unroll
                for (int q = 0; q < 4; ++q) { x[j][q] = fv[2 * j][q] + d[q]; x[j][4 + q] = fv[2 * j + 1][q] + d[4 + q]; } }
            else { float xx[8]; unpack8(xv[j], xx);
#pragma unroll
                for (int q = 0; q < 8; ++q) x[j][q] = xx[q] + d[q]; }
#pragma unroll
            for (int q = 0; q < 8; ++q) s += x[j][q] * x[j][q]; }
        if (Xout) {
#pragma unroll
            for (int j = 0; j < 4; ++j) { v4u o; o.x = pk2(x[j][0], x[j][1]); o.y = pk2(x[j][2], x[j][3]); o.z = pk2(x[j][4], x[j][5]); o.w = pk2(x[j][6], x[j][7]);
                __builtin_nontemporal_store(o, (v4u*)(Xout + (size_t)row * D + 8 * F.lane + 512 * j)); } }
        const float rstd = __builtin_amdgcn_rsqf(wave_sum(s) * (1.0f / D) + EPS);
#pragma unroll
        for (int j = 0; j < 4; ++j) { float y[8];
#pragma unroll
            for (int q = 0; q < 8; ++q) y[q] = x[j][q] * rstd * wq[j][q] + sq[j][q];
            v4u o; o.x = pk2(y[0], y[1]); o.y = pk2(y[2], y[3]); o.z = pk2(y[4], y[5]); o.w = pk2(y[6], y[7]);
            *(v4u*)(H + (size_t)row * D + 8 * F.lane + 512 * j) = o; }
#pragma unroll
        for (int j = 0; j < 4; ++j) { xv[j] = nxv[j]; dv[j] = ndv[j]; }
        if (XF32) {
#pragma unroll
            for (int j = 0; j < 8; ++j) fv[j] = nfv[j]; }
    }
#undef NORM_LOAD
}
__device__ __forceinline__ void final_norm_phase(Frame& F, const bf16* XB, const bf16* DL, const float* w, float* out) {
    const int gw = F.bid * NWAVES + F.wave, NGW = F.G * NWAVES;
    f32x4 wv[8];
#pragma unroll
    for (int j = 0; j < 4; ++j) { wv[2 * j] = *(const f32x4*)(w + 8 * F.lane + 512 * j); wv[2 * j + 1] = *(const f32x4*)(w + 8 * F.lane + 512 * j + 4); }
    v4u xv[4], dv[4], nxv[4], ndv[4];
#define FN_LOAD(row_, xx, dd) do { _Pragma("unroll") for (int j = 0; j < 4; ++j) { const int c_ = 8 * F.lane + 512 * j; xx[j] = *(const v4u*)(XB + (size_t)(row_) * D + c_); dd[j] = *(const v4u*)(DL + (size_t)(row_) * D + c_); } } while (0)
    int row = gw;
    if (row < M) FN_LOAD(row, xv, dv);
    for (; row < M; row += NGW) {
        const int nrow = row + NGW;
        if (nrow < M) FN_LOAD(nrow, nxv, ndv);
        float x[4][8]; float s = 0.f;
#pragma unroll
        for (int j = 0; j < 4; ++j) { float a[8], d[8]; unpack8(xv[j], a); unpack8(dv[j], d);
#pragma unroll
            for (int q = 0; q < 8; ++q) { x[j][q] = a[q] + d[q]; s += x[j][q] * x[j][q]; } }
        const float rstd = __builtin_amdgcn_rsqf(wave_sum(s) * (1.0f / D) + EPS);
#pragma unroll
        for (int j = 0; j < 4; ++j) { float* op = out + (size_t)row * D + 8 * F.lane + 512 * j;
            *(f32x4*)op = (f32x4){x[j][0], x[j][1], x[j][2], x[j][3]} * rstd * wv[2 * j]; *(f32x4*)(op + 4) = (f32x4){x[j][4], x[j][5], x[j][6], x[j][7]} * rstd * wv[2 * j + 1]; }
#pragma unroll
        for (int j = 0; j < 4; ++j) { xv[j] = nxv[j]; dv[j] = ndv[j]; }
    }
#undef FN_LOAD
}

__device__ __forceinline__ int swz(int ob) { return ob ^ (((ob >> 9) & 1) << 5); }
__device__ __forceinline__ int img_off(int r, int c, int KT) { return (((r >> 4) * KT + (c >> 5)) << 10) + swz((r & 15) * 64 + (c & 31) * 2); }
#define FRAG(base, rt, ks, KT, lsw) (*(const LAS bf16x8*)((base) + ((((rt) * (KT)) + (ks)) << 10) + (lsw)))
#define MFMA16(a, b, c) __builtin_amdgcn_mfma_f32_16x16x32_bf16((a), (b), (c), 0, 0, 0)
__device__ __forceinline__ v2u tpack(const v4u (&r)[4], int j) {
    const int d = j >> 1; const unsigned sel = (j & 1) ? 0x07060302u : 0x05040100u;
    v2u o; o.x = __builtin_amdgcn_perm(r[1][d], r[0][d], sel); o.y = __builtin_amdgcn_perm(r[3][d], r[2][d], sel); return o;
}

struct ConvW { f32x4 w0[5], w1[5], b0, b1; };
__device__ __forceinline__ ConvW conv_weights(const float* cw, const float* cb, int ch) {
    ConvW W;
#pragma unroll
    for (int k = 0; k < 5; ++k) { W.w0[k] = *(const f32x4*)(cw + k * CCONV + ch); W.w1[k] = *(const f32x4*)(cw + k * CCONV + ch + 4); }
    W.b0 = *(const f32x4*)(cb + ch); W.b1 = *(const f32x4*)(cb + ch + 4); return W;
}
__device__ __forceinline__ void conv8(const v4u (&r)[12], const ConvW& W, v4u (&out)[8]) {
#pragma unroll
    for (int i = 0; i < 8; ++i) { f32x4 a0 = W.b0, a1 = W.b1;
#pragma unroll
        for (int k = 0; k < 5; ++k) { const v4u v = r[i + k];
            a0 += W.w0[k] * (f32x4){bflo(v.x), bfhi(v.x), bflo(v.y), bfhi(v.y)}; a1 += W.w1[k] * (f32x4){bflo(v.z), bfhi(v.z), bflo(v.w), bfhi(v.w)}; }
        out[i].x = pk2(silu_f(a0.x), silu_f(a0.y)); out[i].y = pk2(silu_f(a0.z), silu_f(a0.w)); out[i].z = pk2(silu_f(a1.x), silu_f(a1.y)); out[i].w = pk2(silu_f(a1.z), silu_f(a1.w)); }
}
__device__ __forceinline__ void conv_rows12(const bf16* PROJ, int t0, int ch, v4u (&r)[12]) {
    int s0, L; if (t0 < MC) { s0 = t0 & ~255; L = 256; } else { s0 = MC + ((t0 - MC) & ~4095); L = 4096; }
#pragma unroll
    for (int j = 0; j < 12; ++j) { const int row = t0 - 2 + j; r[j] = (v4u){0u, 0u, 0u, 0u};
        if (row >= s0 && row < s0 + L) r[j] = *(const v4u*)(PROJ + (size_t)row * PROJ_LD + 6144 + ch); }
}
__device__ __forceinline__ v4u tpack8(const v4u (&o)[8], int j) {
    const int d = j >> 1; const unsigned sel = (j & 1) ? 0x07060302u : 0x05040100u;
    v4u t; t.x = __builtin_amdgcn_perm(o[1][d], o[0][d], sel); t.y = __builtin_amdgcn_perm(o[3][d], o[2][d], sel);
    t.z = __builtin_amdgcn_perm(o[5][d], o[4][d], sel); t.w = __builtin_amdgcn_perm(o[7][d], o[6][d], sel); return t;
}
__device__ __forceinline__ void bc_unit(Frame& F, int chunk, int g, const v4u (&out)[8], bf16* CSN, bf16* BTG, bf16* CBP) {
    LAS unsigned char* L = F.lds; constexpr int O_B = 0, O_C = 32768;
    const int tid = F.tid, lane = F.lane, w = F.wave, fr = lane & 15, fq = lane >> 4, lsw = swz(fr * 64 + fq * 16);
    const int cg = tid & 15, ts = (tid >> 4) & 15, isC = tid >> 8, row0 = chunk * 128;
#pragma unroll
    for (int i = 0; i < 8; ++i) *(LAS v4u*)(L + (isC ? O_C : O_B) + img_off(8 * ts + i, 8 * cg, 4)) = out[i];
    if (isC) {
#pragma unroll
        for (int i = 0; i < 8; ++i) *(v4u*)(CSN + (size_t)(row0 + 8 * ts + i) * 512 + g * 128 + 8 * cg) = out[i];
    } else {
#pragma unroll
        for (int j = 0; j < 8; ++j) *(v4u*)(BTG + ((size_t)(chunk * 4 + g) * 128 + 8 * cg + j) * 128 + 8 * ts) = tpack8(out, j);
    }
    __syncthreads();
    bf16x8 cf[4];
#pragma unroll
    for (int ks = 0; ks < 4; ++ks) cf[ks] = FRAG(L + O_C, w, ks, 4, lsw);
    v2u cbv[8];
#pragma unroll
    for (int st = 0; st < 8; ++st) { f32x4 a = (f32x4){0.f, 0.f, 0.f, 0.f};
#pragma unroll
        for (int ks = 0; ks < 4; ++ks) a = MFMA16(FRAG(L + O_B, st, ks, 4, lsw), cf[ks], a);
        cbv[st].x = pk2(a[0], a[1]); cbv[st].y = pk2(a[2], a[3]); }
    bf16* cp = CBP + ((size_t)(chunk * 4 + g) * 128 + 16 * w + fr) * 128 + fq * 32;
#pragma unroll
    for (int q = 0; q < 4; ++q) *(v4u*)(cp + 8 * q) = (v4u){cbv[2 * q].x, cbv[2 * q].y, cbv[2 * q + 1].x, cbv[2 * q + 1].y};
    __syncthreads();
}
__device__ __forceinline__ void dt_chunk(Frame& F, int chunk, const float* DT, const float* dtb, const float* alog, float* ACS, float* DTV) {
    LAS float* part = (LAS float*)(F.lds + 135168);
    const int lane = F.lane, w = F.wave, dir = lane >> 5;
    const float A = -__expf(alog[lane]), bias = dtb[lane];
    const size_t o0 = ((size_t)chunk * 128 + 16 * w) * 64 + lane;
    float raw[16], dtv[16], cs[16];
#pragma unroll
    for (int i = 0; i < 16; ++i) raw[i] = DT[o0 + (size_t)i * 64];
#pragma unroll
    for (int i = 0; i < 16; ++i) dtv[i] = softplus_f(raw[i] + bias);
    float run = 0.f;
    if (dir) {
#pragma unroll
        for (int i = 15; i >= 0; --i) { run += A * dtv[i]; cs[i] = run; }
    } else {
#pragma unroll
        for (int i = 0; i < 16; ++i) { run += A * dtv[i]; cs[i] = run; }
    }
    part[w * 64 + lane] = run;
    __syncthreads();
    float off = 0.f;
#pragma unroll
    for (int v = 0; v < 8; ++v) { const float pv = part[v * 64 + lane]; if (dir ? (v > w) : (v < w)) off += pv; }
#pragma unroll
    for (int i = 0; i < 16; ++i) { DTV[o0 + (size_t)i * 64] = dtv[i]; ACS[o0 + (size_t)i * 64] = cs[i] + off; }
    __syncthreads();
}
__device__ __forceinline__ void conv_phase(Frame& F, const bf16* PROJ, const float* DT, const float* cw, const float* cb, const float* dtb, const float* alog,
                                           bf16* CSN, bf16* BTG, bf16* CBP, bf16* XST, float* ACS, float* DTV) {
    for (int it = F.bid; it < 192; it += F.G) dt_chunk(F, it, DT, dtb, alog, ACS, DTV);
    {
        const int cg = F.tid & 15, ts = (F.tid >> 4) & 15, isC = F.tid >> 8;
        int u = F.bid;
        if (u < 768) {
            const bool sameg = (F.G & 3) == 0;
            int ch = (isC ? 2560 : 2048) + (u & 3) * 128 + 8 * cg;
            ConvW W = conv_weights(cw, cb, ch);
            v4u r[12], out[8];
            conv_rows12(PROJ, (u >> 2) * 128 + 8 * ts, ch, r);
            for (; u < 768; u += F.G) {
                const int un = u + F.G;
                conv8(r, W, out);
                if (un < 768) { if (!sameg) { ch = (isC ? 2560 : 2048) + (un & 3) * 128 + 8 * cg; W = conv_weights(cw, cb, ch); }
                    conv_rows12(PROJ, (un >> 2) * 128 + 8 * ts, ch, r); }
                bc_unit(F, u >> 2, u & 3, out, CSN, BTG, CBP);
            }
        }
    }
    {
        const int gw = F.bid * NWAVES + F.wave, NGW = F.G * NWAVES, cg = F.lane & 7, ts = F.lane >> 3;
        int it = gw;
        if (it < 12288) {
            const bool sameh = (NGW & 31) == 0;
            int ch = (it & 31) * 64 + 8 * cg;
            ConvW W = conv_weights(cw, cb, ch);
            v4u r[12], rn[12], out[8];
            conv_rows12(PROJ, (it >> 5) * 64 + 8 * ts, ch, r);
            for (; it < 12288; it += NGW) {
                const int itn = it + NGW; int chn = ch;
                if (itn < 12288) { if (!sameh) chn = (itn & 31) * 64 + 8 * cg; conv_rows12(PROJ, (itn >> 5) * 64 + 8 * ts, chn, rn); }
                conv8(r, W, out);
                const int head = it & 31, row0 = (it >> 5) * 64;
                bf16* xp = XST + ((size_t)((row0 >> 7) * 32 + head) * 64 + 8 * cg) * 128 + (row0 & 127) + 8 * ts;
#pragma unroll
                for (int j = 0; j < 8; ++j) *(v4u*)(xp + j * 128) = tpack8(out, j);
                if (itn < 12288) { if (!sameh) { ch = chn; W = conv_weights(cw, cb, ch); }
#pragma unroll
                    for (int j = 0; j < 12; ++j) r[j] = rn[j]; }
            }
        }
    }
}
__device__ __forceinline__ void gmlp_phase(Frame& F, bf16* PROJ, const float* vnorm, const bf16* wsb, const float* bs, int out_off) {
    LAS unsigned char* L = F.lds; constexpr int O_W = 0, O_V = 32768;
    const int tid = F.tid, lane = F.lane, w = F.wave, fr = lane & 15, fq = lane >> 4, lsw = swz(fr * 64 + fq * 16), cg = lane & 31;
    int u = F.bid; if (u >= 1536) return;
    const bool sameg = (F.G & 7) == 0;
    int g = u & 7, gstaged = -1;
    f32x4 nw0, nw1; float bias = 0.f;
    v4u vr[2][4], vn[2][4]; v2u uu[16], un_[16];
#define GM_LOADV(uu_, dst) do { const int row0_ = ((uu_) >> 3) * 128, g_ = (uu_) & 7; _Pragma("unroll") for (int pass = 0; pass < 2; ++pass) { const int rs_ = (tid >> 5) + 16 * pass; \
        _Pragma("unroll") for (int i = 0; i < 4; ++i) dst[pass][i] = *(const v4u*)(PROJ + (size_t)(row0_ + 4 * rs_ + i) * PROJ_LD + 2048 + g_ * 256 + 8 * cg); } } while (0)
#define GM_LOADU(uu_, dst) do { const bf16* ur_ = PROJ + (size_t)(((uu_) >> 3) * 128 + 16 * w + fr) * PROJ_LD + ((uu_) & 7) * 256 + 4 * fq; \
        _Pragma("unroll") for (int ct = 0; ct < 16; ++ct) dst[ct] = *(const v2u*)(ur_ + 16 * ct); } while (0)
    GM_LOADV(u, vr); GM_LOADU(u, uu);
    for (; u < 1536; u += F.G) {
        g = u & 7;
        if (g != gstaged) {
            if (gstaged >= 0) __syncthreads();
#pragma unroll
            for (int q = 0; q < 4; ++q) { const int idx = tid + 512 * q, t = idx >> 4, s8 = idx & 15;
                *(LAS v4u*)(L + O_W + img_off(t, 8 * s8, 4)) = *(const v4u*)(wsb + ((size_t)g * 128 + t) * 128 + 8 * s8); }
            nw0 = *(const f32x4*)(vnorm + g * 256 + 8 * cg); nw1 = *(const f32x4*)(vnorm + g * 256 + 8 * cg + 4); bias = bs[g * 128 + 16 * w + fr]; gstaged = g; }
#pragma unroll
        for (int pass = 0; pass < 2; ++pass) { const int rs = (tid >> 5) + 16 * pass;
            float x[4][8], rstd[4];
#pragma unroll
            for (int i = 0; i < 4; ++i) { float q = 0.f;
#pragma unroll
                for (int d = 0; d < 4; ++d) { x[i][2 * d] = bflo(vr[pass][i][d]); x[i][2 * d + 1] = bfhi(vr[pass][i][d]); q += x[i][2 * d] * x[i][2 * d] + x[i][2 * d + 1] * x[i][2 * d + 1]; }
                q += __shfl_xor(q, 1); q += __shfl_xor(q, 2); q += __shfl_xor(q, 4); q += __shfl_xor(q, 8); q += __shfl_xor(q, 16);
                rstd[i] = __builtin_amdgcn_rsqf(q * (1.0f / 256.f) + EPS); }
#pragma unroll
            for (int j = 0; j < 8; ++j) { const float nw = j < 4 ? nw0[j & 3] : nw1[j & 3];
                v2u o; o.x = pk2(x[0][j] * rstd[0] * nw, x[1][j] * rstd[1] * nw); o.y = pk2(x[2][j] * rstd[2] * nw, x[3][j] * rstd[3] * nw);
                *(LAS v2u*)(L + O_V + img_off(8 * cg + j, 4 * rs, 4)) = o; }
        }
        __syncthreads();
        const int un = u + F.G;
        if (un < 1536) { GM_LOADV(un, vn); GM_LOADU(un, un_); }
        bf16* urow = PROJ + (size_t)((u >> 3) * 128 + 16 * w + fr) * PROJ_LD + g * 256 + 4 * fq;
        bf16x8 af[4];
#pragma unroll
        for (int ks = 0; ks < 4; ++ks) af[ks] = FRAG(L + O_W, w, ks, 4, lsw);
#pragma unroll
        for (int ct = 0; ct < 16; ++ct) { f32x4 a = (f32x4){0.f, 0.f, 0.f, 0.f};
#pragma unroll
            for (int ks = 0; ks < 4; ++ks) a = MFMA16(FRAG(L + O_V, ct, ks, 4, lsw), af[ks], a);
            v2u o; o.x = pk2((a[0] + bias) * bflo(uu[ct].x), (a[1] + bias) * bfhi(uu[ct].x)); o.y = pk2((a[2] + bias) * bflo(uu[ct].y), (a[3] + bias) * bfhi(uu[ct].y));
            *(v2u*)(urow + out_off + 16 * ct) = o; }
        __syncthreads();
        if (un < 1536) {
#pragma unroll
            for (int pass = 0; pass < 2; ++pass)
#pragma unroll
                for (int i = 0; i < 4; ++i) vr[pass][i] = vn[pass][i];
#pragma unroll
            for (int ct = 0; ct < 16; ++ct) uu[ct] = un_[ct]; }
    }
    (void)sameg;
#undef GM_LOADV
#undef GM_LOADU
}

template <int DIR>
__device__ __forceinline__ void ssd_unit(Frame& F, int seq_row0, int nchunks, int head, const float* h0, float* hfin,
                                         const bf16* CSN, const bf16* BTG, const bf16* XST, const bf16* CBP, const float* ACS, const float* DTV, float dskip, bf16* Y) {
    LAS unsigned char* L = F.lds;
    constexpr int dir = DIR;
    constexpr int O_CS = 0, O_BT = 32768, O_XT = 65536, O_HS = 81920, O_E = 98304, O_DT = O_E + 512, O_WG = O_DT + 512, O_V = O_WG + 512, O_R = O_V + 512;
    const int tid = F.tid, lane = F.lane, w = F.wave, fr = lane & 15, fq = lane >> 4;
    const int lsw = swz(fr * 64 + fq * 16), lsw1 = swz(fr * 64 + fq * 8), lsw2 = swz(fr * 64 + 32 + fq * 8);
    const int g = head >> 3, col = dir * 32 + head, last = dir ? 0 : 127;
    const int cgB = tid & 15, rsB = tid >> 4, lidx = 16 * w + fr;
    f32x4 Hacc[4];
#pragma unroll
    for (int pt = 0; pt < 4; ++pt) Hacc[pt] = h0 ? *(const f32x4*)(h0 + (16 * pt + fr) * 128 + 16 * w + 4 * fq) : (f32x4){0.f, 0.f, 0.f, 0.f};
    v4u rc[4], rbt[4], rx[2], rcb[4]; float rE = 0.f, rD = 0.f, rEl = 0.f;
#pragma unroll
    for (int q = 0; q < 4; ++q) rcb[q] = (v4u){0u, 0u, 0u, 0u};
#define SSD_LOADS(cc) do { const size_t r0_ = (size_t)seq_row0 + (size_t)(cc) * 128, ck_ = r0_ >> 7; \
        _Pragma("unroll") for (int i = 0; i < 4; ++i) rc[i] = *(const v4u*)(CSN + (r0_ + 4 * rsB + i) * 512 + g * 128 + 8 * cgB); \
        _Pragma("unroll") for (int q = 0; q < 4; ++q) rbt[q] = *(const v4u*)(BTG + (ck_ * 4 + g) * 16384 + (size_t)(tid + 512 * q) * 8); \
        _Pragma("unroll") for (int q = 0; q < 2; ++q) rx[q] = *(const v4u*)(XST + (ck_ * 32 + head) * 8192 + (size_t)(tid + 512 * q) * 8); \
        _Pragma("unroll") for (int q = 0; q < 4; ++q) { if (dir ? (2 * q + 1 >= w) : (2 * q <= w)) rcb[q] = *(const v4u*)(CBP + ((ck_ * 4 + g) * 128 + lidx) * 128 + fq * 32 + 8 * q); } \
        if (tid < 128) { rE = ACS[(r0_ + tid) * 64 + col]; rD = DTV[(r0_ + tid) * 64 + col]; rEl = ACS[(r0_ + last) * 64 + col]; } } while (0)
#define SSD_WRITE_HS() do { _Pragma("unroll") for (int pt = 0; pt < 4; ++pt) { v2u o_; o_.x = pk2(Hacc[pt][0], Hacc[pt][1]); o_.y = pk2(Hacc[pt][2], Hacc[pt][3]); \
        *(LAS v2u*)(L + O_HS + img_off(16 * pt + fr, 16 * w + 4 * fq, 4)) = o_; } } while (0)
    float dmask[4], dsk[4];
#pragma unroll
    for (int j = 0; j < 4; ++j) { const int sj = 4 * fq + j; dmask[j] = (dir ? (sj < fr) : (sj > fr)) ? 0.f : 1.f; dsk[j] = (!dir && sj == fr) ? dskip : 0.f; }
    int c = dir ? nchunks - 1 : 0;
    SSD_LOADS(c);
    SSD_WRITE_HS();
    for (int step = 0; step < nchunks; ++step) {
        const size_t row0 = (size_t)seq_row0 + (size_t)c * 128;
#pragma unroll
        for (int i = 0; i < 4; ++i) *(LAS v4u*)(L + O_CS + img_off(4 * rsB + i, 8 * cgB, 4)) = rc[i];
#pragma unroll
        for (int q = 0; q < 4; ++q) { const int idx = tid + 512 * q; *(LAS v4u*)(L + O_BT + img_off(idx >> 4, 8 * (idx & 15), 4)) = rbt[q]; }
#pragma unroll
        for (int q = 0; q < 2; ++q) { const int idx = tid + 512 * q; *(LAS v4u*)(L + O_XT + img_off(idx >> 4, 8 * (idx & 15), 4)) = rx[q]; }
        if (tid < 128) {
            const int refl = (lane & 48) | (dir ? 0 : 15);
            const float Rt = __shfl(rE, refl);
            *(LAS float*)(L + O_E + 4 * tid) = rE; *(LAS float*)(L + O_DT + 4 * tid) = rD; *(LAS float*)(L + O_WG + 4 * tid) = rD * __expf(rEl - rE);
            *(LAS float*)(L + O_V + 4 * tid) = rD * __expf(Rt - rE);
            if (lane == refl) *(LAS float*)(L + O_R + 4 * (tid >> 4)) = rE; }
        __syncthreads();
        const float El = *(const LAS float*)(L + O_E + 4 * lidx);
        v2u Mr[8];
        const f32x4 R0 = *(const LAS f32x4*)(L + O_R), R1 = *(const LAS f32x4*)(L + O_R + 16);
        const float Rst[8] = {R0[0], R0[1], R0[2], R0[3], R1[0], R1[1], R1[2], R1[3]};
        f32x4 Vv[8];
#pragma unroll
        for (int st = 0; st < 8; ++st) Vv[st] = *(const LAS f32x4*)(L + O_V + 4 * (16 * st + 4 * fq));
        const f32x4 Esd = *(const LAS f32x4*)(L + O_E + 4 * (16 * w + 4 * fq)), dsd = *(const LAS f32x4*)(L + O_DT + 4 * (16 * w + 4 * fq));
        __builtin_amdgcn_sched_barrier(0);
#pragma unroll
        for (int st = 0; st < 8; ++st) {
            Mr[st] = (v2u){0u, 0u};
            if (dir ? (st >= w) : (st <= w)) {
                const unsigned clo = rcb[st >> 1][(st & 1) * 2], chi = rcb[st >> 1][(st & 1) * 2 + 1];
                float m[4] = {bflo(clo), bfhi(clo), bflo(chi), bfhi(chi)};
                if (st == w) {
                    asm volatile("" ::: "memory");
#pragma unroll
                    for (int j = 0; j < 4; ++j) m[j] = m[j] * (__expf(dmask[j] != 0.f ? El - Esd[j] : 0.f) * dsd[j] * dmask[j]) + dsk[j];
                } else {
                    const float u = __expf(El - Rst[st]);
#pragma unroll
                    for (int j = 0; j < 4; ++j) m[j] = m[j] * (u * Vv[st][j]);
                }
                Mr[st].x = pk2(m[0], m[1]); Mr[st].y = pk2(m[2], m[3]);
            }
        }
        __builtin_amdgcn_sched_barrier(0);
        bf16x8 cf[4], hf[16];
#pragma unroll
        for (int ks = 0; ks < 4; ++ks) cf[ks] = FRAG(L + O_CS, w, ks, 4, lsw);
#pragma unroll
        for (int pt = 0; pt < 4; ++pt)
#pragma unroll
            for (int ks = 0; ks < 4; ++ks) hf[pt * 4 + ks] = FRAG(L + O_HS, pt, ks, 4, lsw);
        const int cn = dir ? c - 1 : c + 1;
        if (step + 1 < nchunks) SSD_LOADS(cn);
        __builtin_amdgcn_sched_barrier(0);
        f32x4 Yv[4];
#pragma unroll
        for (int pt = 0; pt < 4; ++pt) { Yv[pt] = (f32x4){0.f, 0.f, 0.f, 0.f};
#pragma unroll
            for (int ks = 0; ks < 4; ++ks) Yv[pt] = MFMA16(hf[pt * 4 + ks], cf[ks], Yv[pt]); }
        __builtin_amdgcn_sched_barrier(0);
        { const float sc = __expf(El);
#pragma unroll
          for (int pt = 0; pt < 4; ++pt) Yv[pt] *= sc; }
#pragma unroll
        for (int kh = 0; kh < 2; ++kh) {
            v4u xq[8];
#pragma unroll
            for (int k2 = 0; k2 < 2; ++k2)
#pragma unroll
                for (int pt = 0; pt < 4; ++pt) { const LAS unsigned char* xb = L + O_XT + ((pt * 4 + 2 * kh + k2) << 10); xq[k2 * 4 + pt].xy = *(const LAS v2u*)(xb + lsw1); xq[k2 * 4 + pt].zw = *(const LAS v2u*)(xb + lsw2); }
            __builtin_amdgcn_sched_barrier(0);
#pragma unroll
            for (int k2 = 0; k2 < 2; ++k2) { const int ks = 2 * kh + k2;
                if (dir ? (2 * ks + 1 >= w) : (2 * ks <= w)) {
                    const v4u mv = (v4u){Mr[2 * ks].x, Mr[2 * ks].y, Mr[2 * ks + 1].x, Mr[2 * ks + 1].y};
                    const bf16x8 mf = __builtin_bit_cast(bf16x8, mv);
#pragma unroll
                    for (int pt = 0; pt < 4; ++pt) Yv[pt] = MFMA16(__builtin_bit_cast(bf16x8, xq[k2 * 4 + pt]), mf, Yv[pt]);
                } }
            __builtin_amdgcn_sched_barrier(0);
        }
        __builtin_amdgcn_sched_barrier(0);
        bf16x8 bfr[4];
        { v4u bv[4]; f32x4 g0[4], g1[4];
#pragma unroll
          for (int ks = 0; ks < 4; ++ks) { bv[ks] = __builtin_bit_cast(v4u, FRAG(L + O_BT, w, ks, 4, lsw));
              g0[ks] = *(const LAS f32x4*)(L + O_WG + 4 * (32 * ks + 8 * fq)); g1[ks] = *(const LAS f32x4*)(L + O_WG + 4 * (32 * ks + 8 * fq + 4)); }
          __builtin_amdgcn_sched_barrier(0);
#pragma unroll
          for (int ks = 0; ks < 4; ++ks) { v4u b = bv[ks];
              b.x = pk2(bflo(b.x) * g0[ks][0], bfhi(b.x) * g0[ks][1]); b.y = pk2(bflo(b.y) * g0[ks][2], bfhi(b.y) * g0[ks][3]);
              b.z = pk2(bflo(b.z) * g1[ks][0], bfhi(b.z) * g1[ks][1]); b.w = pk2(bflo(b.w) * g1[ks][2], bfhi(b.w) * g1[ks][3]);
              bfr[ks] = __builtin_bit_cast(bf16x8, b); } }
        __builtin_amdgcn_sched_barrier(0);
        bf16x8 xf[16];
#pragma unroll
        for (int ks = 0; ks < 4; ++ks)
#pragma unroll
            for (int pt = 0; pt < 4; ++pt) xf[ks * 4 + pt] = FRAG(L + O_XT, pt, ks, 4, lsw);
        const float dec = __expf(*(const LAS float*)(L + O_E + 4 * last));
#pragma unroll
        for (int pt = 0; pt < 4; ++pt) { v2u o; o.x = pk2(Yv[pt][0], Yv[pt][1]); o.y = pk2(Yv[pt][2], Yv[pt][3]);
            *(v2u*)(Y + (row0 + lidx) * D + head * 64 + 16 * pt + 4 * fq) = o; }
        __builtin_amdgcn_sched_barrier(0);
#pragma unroll
        for (int pt = 0; pt < 4; ++pt) Hacc[pt] *= dec;
#pragma unroll
        for (int ks = 0; ks < 4; ++ks)
#pragma unroll
            for (int pt = 0; pt < 4; ++pt) Hacc[pt] = MFMA16(bfr[ks], xf[ks * 4 + pt], Hacc[pt]);
        __syncthreads();
        SSD_WRITE_HS();
        c = cn;
    }
    if (hfin) {
#pragma unroll
        for (int pt = 0; pt < 4; ++pt) *(f32x4*)(hfin + (16 * pt + fr) * 128 + 16 * w + 4 * fq) = Hacc[pt]; }
    __syncthreads();
#undef SSD_LOADS
#undef SSD_WRITE_HS
}

__device__ __forceinline__ void ssd_combine_phase(Frame& F, const bf16* YF, const bf16* YB, bf16* PROJ, const float* nw) {
    const int gw = F.bid * NWAVES + F.wave, NGW = F.G * NWAVES;
    v4u a[4], b[4], z[4], na[4], nb[4], nz[4];
    f32x4 nwv[8];
#pragma unroll
    for (int j = 0; j < 4; ++j) { nwv[2 * j] = *(const f32x4*)(nw + 8 * F.lane + 512 * j); nwv[2 * j + 1] = *(const f32x4*)(nw + 8 * F.lane + 512 * j + 4); }
#define CMB_LOAD(row_, aa, bb, zz) do { _Pragma("unroll") for (int j = 0; j < 4; ++j) { const int c_ = 8 * F.lane + 512 * j; \
        aa[j] = *(const v4u*)(YF + (size_t)(row_) * D + c_); bb[j] = *(const v4u*)(YB + (size_t)(row_) * D + c_); zz[j] = *(const v4u*)(PROJ + (size_t)(row_) * PROJ_LD + 4096 + c_); } } while (0)
    int row = gw;
    if (row < M) CMB_LOAD(row, a, b, z);
    for (; row < M; row += NGW) {
        const int nrow = row + NGW;
        if (nrow < M) CMB_LOAD(nrow, na, nb, nz);
        float y[32]; float s = 0.f;
#pragma unroll
        for (int j = 0; j < 4; ++j) {
#pragma unroll
            for (int q = 0; q < 4; ++q) { const float lo = (bflo(a[j][q]) + bflo(b[j][q])) * bflo(z[j][q]), hi = (bfhi(a[j][q]) + bfhi(b[j][q])) * bfhi(z[j][q]);
                y[8 * j + 2 * q] = lo; y[8 * j + 2 * q + 1] = hi; s += lo * lo + hi * hi; } }
        const float rstd = __builtin_amdgcn_rsqf(wave_sum(s) * (1.0f / D) + EPS);
#pragma unroll
        for (int j = 0; j < 4; ++j) { const int c = 8 * F.lane + 512 * j; const f32x4 w0 = nwv[2 * j], w1 = nwv[2 * j + 1];
            v4u o; o.x = pk2(y[8 * j] * rstd * w0.x, y[8 * j + 1] * rstd * w0.y); o.y = pk2(y[8 * j + 2] * rstd * w0.z, y[8 * j + 3] * rstd * w0.w);
            o.z = pk2(y[8 * j + 4] * rstd * w1.x, y[8 * j + 5] * rstd * w1.y); o.w = pk2(y[8 * j + 6] * rstd * w1.z, y[8 * j + 7] * rstd * w1.w);
            *(v4u*)(PROJ + (size_t)row * PROJ_LD + 2048 + c) = o; }
#pragma unroll
        for (int j = 0; j < 4; ++j) { a[j] = na[j]; b[j] = nb[j]; z[j] = nz[j]; }
    }
#undef CMB_LOAD
}

template <int K>
__device__ __forceinline__ void pool_run(int r0, int a0, int W, int ch, const bf16* HC, bf16* PL) {
    constexpr int NR = 8 + K - 1;
    v4u r[NR], nx[8];
#define POOL_ROW(dst, row_) do { const int rr_ = (row_); dst = (v4u){0u, 0u, 0u, 0u}; if (rr_ >= a0 && rr_ < a0 + W) dst = *(const v4u*)(HC + (size_t)rr_ * D + ch); } while (0)
#pragma unroll
    for (int j = 0; j < NR; ++j) POOL_ROW(r[j], r0 - K / 2 + j);
#pragma unroll
    for (int blk = 0; blk < 2; ++blk) {
        const int t0 = r0 + 8 * blk;
        if (blk == 0) {
#pragma unroll
            for (int i = 0; i < 8; ++i) POOL_ROW(nx[i], t0 - K / 2 + NR + i); }
        float s[8] = {0.f, 0.f, 0.f, 0.f, 0.f, 0.f, 0.f, 0.f};
#pragma unroll
        for (int j = 0; j < K; ++j) {
#pragma unroll
            for (int q = 0; q < 4; ++q) { s[2 * q] += bflo(r[j][q]); s[2 * q + 1] += bfhi(r[j][q]); } }
#pragma unroll
        for (int i = 0; i < 8; ++i) {
            if (i > 0) {
#pragma unroll
                for (int q = 0; q < 4; ++q) { s[2 * q] += bflo(r[i + K - 1][q]) - bflo(r[i - 1][q]); s[2 * q + 1] += bfhi(r[i + K - 1][q]) - bfhi(r[i - 1][q]); } }
            const int t = t0 + i - a0; int lo = t - K / 2; if (lo < 0) lo = 0; int hi = t - K / 2 + K; if (hi > W) hi = W;
            const float inv = 1.0f / (float)(hi - lo);
            const v4u x = r[i + K / 2]; v4u o;
#pragma unroll
            for (int q = 0; q < 4; ++q) o[q] = pk2(s[2 * q] * inv - bflo(x[q]), s[2 * q + 1] * inv - bfhi(x[q]));
            *(v4u*)(PL + (size_t)(t0 + i) * D + ch) = o; }
        if (blk == 0) {
#pragma unroll
            for (int j = 0; j < NR - 8; ++j) r[j] = r[j + 8];
#pragma unroll
            for (int i = 0; i < 8; ++i) r[NR - 8 + i] = nx[i]; }
    }
#undef POOL_ROW
}
__device__ __forceinline__ void pool_phase(Frame& F, const bf16* HC, bf16* PL) {
    const int gw = F.bid * NWAVES + F.wave, NGW = F.G * NWAVES;
    for (int it = gw; it < (M / 16) * 4; it += NGW) {
        const int g = it & 3, r0 = (it >> 2) * 16, ch = g * 512 + 8 * F.lane;
        int a0, W; if (r0 < MC) { a0 = r0 & ~255; W = 256; } else { a0 = r0 & ~63; W = 64; }
        if (g == 0) pool_run<2>(r0, a0, W, ch, HC, PL); else if (g == 1) pool_run<4>(r0, a0, W, ch, HC, PL);
        else if (g == 2) pool_run<8>(r0, a0, W, ch, HC, PL); else pool_run<16>(r0, a0, W, ch, HC, PL);
    }
}

constexpr int NPHASES = 39;
#define WSP(T, off) ((T*)(ws + (off)))
__global__ void __launch_bounds__(NTHR, 2) mega_fwd(Args args_by_value) {
    extern __shared__ __attribute__((aligned(16))) unsigned char lds[];
    int lo, hi;
    XcdBarrier bar;
    { CArgs* A = kargs(0); lo = A->ph_lo; hi = A->ph_hi;
      if (threadIdx.x < 64) ((LAS unsigned*)((LAS unsigned char*)lds + MISC_OFF))[threadIdx.x] = 0u;
      __syncthreads();
      bar = xcd_barrier_post((unsigned*)(A->ws + WS_CTL) + CW_BAR + A->li * XCD_BAR_WORDS, (volatile LAS unsigned*)((LAS unsigned char*)lds + MISC_OFF) + 8); }
#define IN(k) (lo <= (k) && (k) < hi)
#define SEAM(k) do { if (IN((k) + 1)) { xcd_barrier(bar); if (PROBE_REP_MASK & 256) xcd_barrier(bar); } } while (0)
#define REP_BEGIN(bit) _Pragma("unroll") for (int rep_ = 0; rep_ < (((PROBE_REP_MASK) >> (bit)) & 1) + 1; ++rep_) { if (rep_) xcd_barrier(bar);
#define REP_END }

    if (IN(0)) { REP_BEGIN(0) CArgs* A = kargs(0); Frame F = mkframe(A); p0_prologue(F, *A); REP_END SEAM(0); }
    if (IN(1)) { CArgs* A = kargs(1); Frame F = mkframe(A); unsigned char* ws = A->ws;
        pg8::Gemm g{WSP(const bf16, WS_WOUTO), WSP(const bf16, WS_WPOOL), 2 * D, D, 512, D, 2, 8}; pg8::StaticOrder S; S.init(2 * D, D, F.G, F.bid);
        pg8::EpiBf16 E{WSP(bf16, WS_W2T), D, nullptr};
        pg8::gemm_phase<pg8::EpiBf16, pg8::StaticOrder, true, true>(F.lds, g, S, E);
        __syncthreads();
    }

    for (int l = 0; l < DEPTH; ++l) {
        const int pb = 2 + 9 * l, e = l >> 1;
        if (IN(pb + 0)) { CArgs* A = kargs(pb); Frame F = mkframe(A); unsigned char* ws = A->ws; bf16* XB = WSP(bf16, WS_X);
            if (l == 0) norm_phase<true>(F, A->in[I_XP], A->in[I_XS], nullptr, nullptr, nullptr, A->in[I_NMIX] + l * D, WSP(const float, WS_MOD) + (size_t)l * 5 * NMOD, 0, WSP(bf16, WS_H));
            else norm_phase<false>(F, nullptr, nullptr, XB, WSP(const bf16, WS_DELTA), XB, A->in[I_NMIX] + l * D, WSP(const float, WS_MOD) + (size_t)l * 5 * NMOD, 0, WSP(bf16, WS_H));
            SEAM(pb + 0); }
        if ((l & 1) == 0) {
            if (IN(pb + 1)) { REP_BEGIN(2) CArgs* A = kargs(pb + 1); Frame F = mkframe(A); unsigned char* ws = A->ws;
                pg8::Gemm g{WSP(bf16, WS_H), WSP(const bf16, WS_WINE) + (size_t)e * IN_PAD * D, M, IN_PAD, D, D, 0, 0}; pg8::StaticOrder S; S.init(M, IN_PAD, F.G, F.bid);
                pg8::EpiInEven E{WSP(bf16, WS_PROJ), WSP(float, WS_DT)};
                pg8::gemm_phase<pg8::EpiInEven, pg8::StaticOrder, true, true>(F.lds, g, S, E);
                REP_END SEAM(pb + 1);
            }
            if (IN(pb + 2)) {
                REP_BEGIN(3)
                { CArgs* A = kargs(pb + 2); Frame F = mkframe(A); unsigned char* ws = A->ws;
                  conv_phase(F, WSP(const bf16, WS_PROJ), WSP(const float, WS_DT), A->in[I_CONVW] + (size_t)e * 5 * CCONV, A->in[I_CONVB] + (size_t)e * CCONV, A->in[I_DTB] + e * 64, A->in[I_ALOG] + e * 64,
                             WSP(bf16, WS_CSN), WSP(bf16, WS_BTG), WSP(bf16, WS_CBP), WSP(bf16, WS_XST), WSP(float, WS_ACS), WSP(float, WS_DTV)); }
                REP_END
                _Pragma("unroll") for (int rep_ = 0; rep_ < (((PROBE_REP_MASK) >> 13) & 1) + 1; ++rep_) { if (rep_) xcd_barrier(bar);
                { CArgs* A = kargs(pb + 2 + rep_); Frame F = mkframe(A); unsigned char* ws = A->ws;
                  gmlp_phase(F, WSP(bf16, WS_PROJ), A->in[I_GNORM] + e * D, WSP(const bf16, WS_GWSB) + (size_t)e * 8 * 128 * 128, A->in[I_GBS] + e * 8 * 128, rep_ ? 2048 : 0); } }
                SEAM(pb + 2);
            }
            if (IN(pb + 3)) {
                REP_BEGIN(4) for (int u = blockIdx.x; u < 2304; u += gridDim.x) { CArgs* A = kargs(u); Frame F = mkframe(A); unsigned char* ws = A->ws;
                    int b, head, dir, k;
                    if (F.G == 256) { k = u >> 8; const int x = F.bid & 7, combo = (k == 0 ? 0 : (k - 1) * 8) + x; b = combo >> 1; dir = combo & 1; head = F.bid >> 3; }
                    else { k = u < 256 ? 0 : 1; const int v = k == 0 ? u : u - 256; b = v >> 6; head = (v >> 1) & 31; dir = v & 1; }
                    int seq0, nch; const float* h0 = nullptr; float* hf = nullptr;
                    if (k == 0) { seq0 = MC + b * SEQ_S; nch = SEQ_S / 128; h0 = A->in[I_STATE] + ((((size_t)b * 2 + e) * 2 + dir) * NH + head) * (HP * NST); }
                    else { seq0 = b * SEQ_C; nch = SEQ_C / 128; hf = A->out + (size_t)M * D + ((((size_t)b * 2 + e) * 2 + dir) * NH + head) * (HP * NST); }
                    if (dir) ssd_unit<1>(F, seq0, nch, head, h0, hf, WSP(const bf16, WS_CSN), WSP(const bf16, WS_BTG), WSP(const bf16, WS_XST), WSP(const bf16, WS_CBP), WSP(const float, WS_ACS), WSP(const float, WS_DTV), 0.f, WSP(bf16, WS_YB));
                    else ssd_unit<0>(F, seq0, nch, head, h0, hf, WSP(const bf16, WS_CSN), WSP(const bf16, WS_BTG), WSP(const bf16, WS_XST), WSP(const bf16, WS_CBP), WSP(const float, WS_ACS), WSP(const float, WS_DTV), A->in[I_SSDD][e * NH + head], WSP(bf16, WS_YF));
                } REP_END
                SEAM(pb + 3);
            }
            if (IN(pb + 4)) { REP_BEGIN(5) CArgs* A = kargs(pb + 4); Frame F = mkframe(A); unsigned char* ws = A->ws;
                ssd_combine_phase(F, WSP(const bf16, WS_YF), WSP(const bf16, WS_YB), WSP(bf16, WS_PROJ), A->in[I_SNORM] + e * D); REP_END SEAM(pb + 4); }
        } else {
            if (IN(pb + 1)) { REP_BEGIN(9) CArgs* A = kargs(pb + 1); Frame F = mkframe(A); unsigned char* ws = A->ws;
                pg8::Gemm g{WSP(bf16, WS_H), WSP(const bf16, WS_WINO) + (size_t)e * D * D, M, D, D, D, 0, 0}; pg8::StaticOrder S; S.init(M, D, F.G, F.bid, 4);
                pg8::EpiBf16 E{WSP(bf16, WS_HC), D, nullptr};
                pg8::gemm_phase<pg8::EpiBf16, pg8::StaticOrder, true, true>(F.lds, g, S, E);
                REP_END SEAM(pb + 1);
            }
            if (IN(pb + 2)) { REP_BEGIN(6) CArgs* A = kargs(pb + 2); Frame F = mkframe(A); unsigned char* ws = A->ws; pool_phase(F, WSP(const bf16, WS_HC), WSP(bf16, WS_PL)); REP_END SEAM(pb + 2); }
        }
        if (IN(pb + 5)) { REP_BEGIN(11) CArgs* A = kargs(pb + 5); Frame F = mkframe(A); unsigned char* ws = A->ws;
            const bool ev = (l & 1) == 0;
            pg8::Gemm g{ev ? WSP(const bf16, WS_PROJ) : WSP(const bf16, WS_PL), ev ? WSP(const bf16, WS_WOUTE) + (size_t)e * D * 4096 : WSP(const bf16, WS_W2T) + (size_t)e * D * D, M, D, ev ? 4096 : D, ev ? PROJ_LD : D, 0, 0};
            pg8::StaticOrder S; S.init(M, D, F.G, F.bid, 4);
            pg8::EpiDelta E{WSP(bf16, WS_DELTA), WSP(const float, WS_MOD) + (size_t)l * 5 * NMOD + 2 * D};
            pg8::gemm_phase<pg8::EpiDelta, pg8::StaticOrder, true, true>(F.lds, g, S, E);
            REP_END SEAM(pb + 5);
        }
        if (IN(pb + 6)) { CArgs* A = kargs(pb + 6); Frame F = mkframe(A); unsigned char* ws = A->ws; bf16* XB = WSP(bf16, WS_X);
            if (l == 0) norm_phase<true>(F, A->in[I_XP], A->in[I_XS], nullptr, WSP(const bf16, WS_DELTA), XB, A->in[I_NFFN] + l * D, WSP(const float, WS_MOD) + (size_t)l * 5 * NMOD, 3, WSP(bf16, WS_H));
            else norm_phase<false>(F, nullptr, nullptr, XB, WSP(const bf16, WS_DELTA), XB, A->in[I_NFFN] + l * D, WSP(const float, WS_MOD) + (size_t)l * 5 * NMOD, 3, WSP(bf16, WS_H));
            SEAM(pb + 6); }
        if (IN(pb + 7)) { REP_BEGIN(7) CArgs* A = kargs(pb + 7); Frame F = mkframe(A); unsigned char* ws = A->ws;
            pg8::Gemm g{WSP(bf16, WS_H), WSP(const bf16, WS_WUP) + (size_t)l * NFU * D, M, NFU, D, D, 0, 0}; pg8::StaticOrder S; S.init(M, NFU, F.G, F.bid);
            pg8::EpiFfnUp E{WSP(bf16, WS_G)};
            pg8::gemm_phase<pg8::EpiFfnUp, pg8::StaticOrder, true, true>(F.lds, g, S, E);
            REP_END
            {
                CArgs* A = kargs(pb + 7); Frame F = mkframe(A);
                const int nwg = (M / 256) * (NFU / 256), busy = nwg % F.G;
                if (busy == 0) convert_items(F, *A, 1 + l, F.bid * NWAVES + F.wave, F.G * NWAVES);
                else if (F.bid >= busy) convert_items(F, *A, 1 + l, (F.bid - busy) * NWAVES + F.wave, (F.G - busy) * NWAVES);
            }
            SEAM(pb + 7);
        }
        if (IN(pb + 8)) { REP_BEGIN(12) CArgs* A = kargs(pb + 8); Frame F = mkframe(A); unsigned char* ws = A->ws;
            pg8::Gemm g{WSP(bf16, WS_G), WSP(const bf16, WS_WDN) + (size_t)l * D * FF, M, D, FF, FF, 0, 0}; pg8::StaticOrder S; S.init(M, D, F.G, F.bid, 4);
            pg8::EpiDelta E{WSP(bf16, WS_DELTA), WSP(const float, WS_MOD) + (size_t)l * 5 * NMOD + 5 * D};
            pg8::gemm_phase<pg8::EpiDelta, pg8::StaticOrder, true, true>(F.lds, g, S, E);
            REP_END SEAM(pb + 8);
        }
    }
    if (IN(38)) { CArgs* A = kargs(38); Frame F = mkframe(A); unsigned char* ws = A->ws; final_norm_phase(F, WSP(const bf16, WS_X), WSP(const bf16, WS_DELTA), A->in[I_FNORM], A->out); }
#undef IN
#undef SEAM
}

extern "C" void kernel_launch(void* const* d_in, const int* in_sizes, int n_in, void* d_out, int out_size, void* d_ws, size_t ws_size, hipStream_t stream) {
    static int grid = 0;
    if (grid == 0) {
        if (n_in != 28 || ws_size < WS_END) { fprintf(stderr, "kernel_launch: unexpected n_in %d / ws_size %zu (need %zu)\n", n_in, ws_size, (size_t)WS_END); grid = -1; return; }
        int dev = 0, cus = 0, per_cu = 0;
        if (hipGetDevice(&dev) != hipSuccess || hipDeviceGetAttribute(&cus, hipDeviceAttributeMultiprocessorCount, dev) != hipSuccess) { grid = -1; return; }
        if (hipFuncSetAttribute((const void*)mega_fwd, hipFuncAttributeMaxDynamicSharedMemorySize, LDS_BYTES) != hipSuccess) { fprintf(stderr, "kernel_launch: hipFuncSetAttribute failed\n"); grid = -1; return; }
        if (hipOccupancyMaxActiveBlocksPerMultiprocessor(&per_cu, (const void*)mega_fwd, NTHR, LDS_BYTES) != hipSuccess || per_cu < 1) fprintf(stderr, "kernel_launch: occupancy query says %d\n", per_cu);
        (void)hipGetLastError();
        grid = cus;
    }
    if (grid < 0) return;
    if (hipMemsetAsync((char*)d_ws + WS_CTL, 0, CTL_ZERO_BYTES, stream) != hipSuccess) return;
    Args a{};
    for (int i = 0; i < 28; ++i) a.in[i] = (const float*)d_in[i];
    a.out = (float*)d_out; a.ws = (unsigned char*)d_ws; a.pad = 0;
#if MK_PER_PHASE
    for (int ph = 0; ph < NPHASES; ++ph) { a.ph_lo = ph; a.ph_hi = ph + 1; a.li = 0;
        hipLaunchKernelGGL(mega_fwd, dim3(grid), dim3(NTHR), LDS_BYTES, stream, a); }
#else
    a.ph_lo = 0; a.ph_hi = NPHASES; a.li = 0;
    hipLaunchKernelGGL(mega_fwd, dim3(grid), dim3(NTHR), LDS_BYTES, stream, a);
#endif
}
```
